# Optimizing an MI355X kernel written in HIP

```python
import math
import jax
import jax.numpy as jnp
from jax import lax
import numpy as np

D_MODEL = 2048
BATCH = 4
SEQ = 2048
DEPTH = 2
DEC_BATCH = 128
DEC_SEQ = 8
PAST_LEN = 16384
PAGE_SIZE = 128

EPS = 1e-6
GLA_WIDTH = D_MODEL // 2
GLA_HEADS = 4
GLA_DV = GLA_WIDTH // GLA_HEADS
GLA_DK = GLA_DV // 2
GLA_LOWRANK = 16
GK_NORM = 16.0
GLA_CHUNK = 64
POOL_WIDTH = D_MODEL - GLA_WIDTH
POOL_WINDOWS = (2, 4, 8, 16)
POOL_GROUPS = 4
POOL_GC = POOL_WIDTH // POOL_GROUPS
POOL_BUF = 15
D_FF = ((8 * D_MODEL // 3 + 255) // 256) * 256
Q_END = GLA_HEADS * GLA_DK
K_END = Q_END + GLA_HEADS * GLA_DK
V_END = K_END + GLA_WIDTH
G_END = V_END + GLA_WIDTH
GK_END = G_END + GLA_LOWRANK
IN_WIDTH = GK_END + POOL_WIDTH

kernel_name = "hymba_gla_pool_decoder_step"


def rmsnorm(x, g):
    xf = x.astype(jnp.float32)
    r = lax.rsqrt(jnp.mean(xf * xf, axis=-1, keepdims=True) + EPS)
    return (xf * r).astype(x.dtype) * g


def gla(q, k, v, gk, s0):
    B, T = q.shape[0], q.shape[1]
    c = math.gcd(T, GLA_CHUNK)
    n = T // c

    def split(a):
        return a.reshape(B, n, c, a.shape[2], a.shape[3]).transpose(1, 0, 3, 2, 4)

    qc, kc, vc, gc = split(q), split(k), split(v), split(gk)
    causal = jnp.tril(jnp.ones((c, c), dtype=bool))[:, :, None]

    def step(S, inp):
        qi, ki, vi, gi = inp
        b = jnp.cumsum(gi.astype(jnp.float32), axis=2)
        diff = b[:, :, :, None, :] - b[:, :, None, :, :]
        decay = jnp.exp(jnp.where(causal, diff, -jnp.inf))
        scores = jnp.einsum('bhid,bhjd,bhijd->bhij', qi.astype(jnp.float32), ki.astype(jnp.float32), decay)
        o_intra = jnp.einsum('bhij,bhjv->bhiv', scores, vi.astype(jnp.float32))
        o_inter = jnp.einsum('bhid,bhdv->bhiv', qi.astype(jnp.float32) * jnp.exp(b), S)
        b_last = b[:, :, -1:, :]
        k_dec = ki.astype(jnp.float32) * jnp.exp(b_last - b)
        S_new = jnp.exp(b_last[:, :, 0, :])[..., None] * S + jnp.einsum('bhjd,bhjv->bhdv', k_dec, vi.astype(jnp.float32))
        return S_new, o_intra + o_inter

    S_fin, o = lax.scan(step, s0.astype(jnp.float32), (qc, kc, vc, gc))
    o = o.transpose(1, 0, 3, 2, 4).reshape(B, T, GLA_HEADS, GLA_DV)
    return o.astype(q.dtype), S_fin.astype(s0.dtype)


def pool_mixer(u, buf, pos0, w_pool, pool_scale):
    B, T = u.shape[0], u.shape[1]
    ext = jnp.concatenate([buf.astype(u.dtype), u], axis=1)
    cs = jnp.cumsum(ext.astype(jnp.float32), axis=1)
    cs = jnp.pad(cs, ((0, 0), (1, 0), (0, 0)))
    pos = pos0 + jnp.arange(T)
    outs = []
    for i, w in enumerate(POOL_WINDOWS):
        lo, hi = i * POOL_GC, (i + 1) * POOL_GC
        s = cs[:, POOL_BUF + 1:POOL_BUF + 1 + T, lo:hi] - cs[:, POOL_BUF + 1 - w:POOL_BUF + 1 - w + T, lo:hi]
        cnt = jnp.minimum(w, pos + 1).astype(jnp.float32)[None, :, None]
        outs.append(s / cnt - u[..., lo:hi].astype(jnp.float32))
    d = jnp.stack(outs, axis=2).astype(u.dtype)
    y = jnp.einsum('btgc,gcd->btgd', d, w_pool).reshape(B, T, POOL_WIDTH) * pool_scale
    return y, ext[:, -POOL_BUF:]


def mixer(h, s_gla, buf, pos0, w_in, w_gk_up, b_gk, gla_norm, w_pool, pool_scale, w_out):
    B, T = h.shape[0], h.shape[1]
    proj = h @ w_in
    q = proj[..., :Q_END].reshape(B, T, GLA_HEADS, GLA_DK) * (GLA_DK ** -0.5)
    k = proj[..., Q_END:K_END].reshape(B, T, GLA_HEADS, GLA_DK)
    v = proj[..., K_END:V_END].reshape(B, T, GLA_HEADS, GLA_DV)
    g = proj[..., V_END:G_END]
    gk_lr = proj[..., G_END:GK_END]
    u = proj[..., GK_END:]
    gk = jax.nn.log_sigmoid((gk_lr @ w_gk_up + b_gk).astype(jnp.float32)) / GK_NORM
    gk = gk.reshape(B, T, GLA_HEADS, GLA_DK)
    o, s_new = gla(q, k, v, gk, s_gla)
    o = rmsnorm(o, gla_norm).reshape(B, T, GLA_WIDTH) * jax.nn.silu(g)
    p, buf_new = pool_mixer(u, buf, pos0, w_pool, pool_scale)
    out = jnp.concatenate([o, p.astype(o.dtype)], axis=-1) @ w_out
    return out, s_new, buf_new


def trunk(x, s_gla_all, buf_all, pos0, norm_mix, w_in, w_gk_up, b_gk, gla_norm, w_pool,
          pool_scale, w_out, norm_ffn, w_gate, w_up, w_down, norm_final):
    new_s, new_b = [], []
    for l in range(DEPTH):
        h = rmsnorm(x, norm_mix[l])
        m, s, b = mixer(h, s_gla_all[l], buf_all[l], pos0, w_in[l], w_gk_up[l], b_gk[l],
                        gla_norm[l], w_pool[l], pool_scale[l], w_out[l])
        x = x + m
        h = rmsnorm(x, norm_ffn[l])
        x = x + (jax.nn.silu(h @ w_gate[l]) * (h @ w_up[l])) @ w_down[l]
        new_s.append(s)
        new_b.append(b)
    return rmsnorm(x, norm_final), jnp.stack(new_s), jnp.stack(new_b)


def setup_inputs(seed: int = 0) -> dict:
    key = jax.random.key(seed)
    ks = jax.random.split(key, 20)
    f = jnp.float32
    nrm = lambda k, shape, s: jax.random.normal(k, shape, f) * s
    return {
        "x_prompt": nrm(ks[0], (BATCH, SEQ, D_MODEL), 1.0),
        "x_sample": nrm(ks[1], (DEC_BATCH, DEC_SEQ, D_MODEL), 1.0),
        "state_gla": nrm(ks[2], (DEPTH, DEC_BATCH, GLA_HEADS, GLA_DK, GLA_DV), 0.5),
        "state_pool": nrm(ks[3], (DEPTH, DEC_BATCH, POOL_BUF, POOL_WIDTH), 1.0),
        "norm_mix": 1.0 + nrm(ks[4], (DEPTH, D_MODEL), 0.01),
        "w_in": nrm(ks[5], (DEPTH, D_MODEL, IN_WIDTH), D_MODEL ** -0.5),
        "w_gk_up": nrm(ks[6], (DEPTH, GLA_LOWRANK, GLA_HEADS * GLA_DK), GLA_LOWRANK ** -0.5),
        "b_gk": nrm(ks[7], (DEPTH, GLA_HEADS * GLA_DK), 0.01),
        "gla_norm": 1.0 + nrm(ks[8], (DEPTH, GLA_DV), 0.01),
        "w_pool": nrm(ks[9], (DEPTH, POOL_GROUPS, POOL_GC, POOL_GC), POOL_GC ** -0.5),
        "pool_scale": 1.0 + nrm(ks[10], (DEPTH, POOL_WIDTH), 0.01),
        "w_out": nrm(ks[11], (DEPTH, D_MODEL, D_MODEL), D_MODEL ** -0.5),
        "norm_ffn": 1.0 + nrm(ks[12], (DEPTH, D_MODEL), 0.01),
        "w_gate": nrm(ks[13], (DEPTH, D_MODEL, D_FF), D_MODEL ** -0.5),
        "w_up": nrm(ks[14], (DEPTH, D_MODEL, D_FF), D_MODEL ** -0.5),
        "w_down": nrm(ks[15], (DEPTH, D_FF, D_MODEL), D_FF ** -0.5),
        "norm_final": 1.0 + nrm(ks[16], (D_MODEL,), 0.01),
    }


def reference(x_prompt, x_sample, state_gla, state_pool, norm_mix, w_in, w_gk_up, b_gk,
              gla_norm, w_pool, pool_scale, w_out, norm_ffn, w_gate, w_up, w_down, norm_final):
    s0_prompt = jnp.zeros((DEPTH, BATCH, GLA_HEADS, GLA_DK, GLA_DV), x_prompt.dtype)
    b0_prompt = jnp.zeros((DEPTH, BATCH, POOL_BUF, POOL_WIDTH), x_prompt.dtype)
    y_prompt, state_gla_prompt, state_pool_prompt = trunk(
        x_prompt, s0_prompt, b0_prompt, 0, norm_mix, w_in, w_gk_up, b_gk, gla_norm, w_pool,
        pool_scale, w_out, norm_ffn, w_gate, w_up, w_down, norm_final)
    y_sample, state_gla_sample, state_pool_sample = trunk(
        x_sample, state_gla, state_pool, PAST_LEN, norm_mix, w_in, w_gk_up, b_gk, gla_norm, w_pool,
        pool_scale, w_out, norm_ffn, w_gate, w_up, w_down, norm_final)
    return (y_prompt, y_sample, state_gla_prompt, state_pool_prompt, state_gla_sample, state_pool_sample)
```

```cpp
#include <hip/hip_runtime.h>
#include <cstdio>
#include <cstdint>

#define LAS __attribute__((address_space(3)))
#define GAS __attribute__((address_space(1)))
typedef unsigned short bf16_t;
typedef short bf16x8 __attribute__((ext_vector_type(8)));
typedef float f32x4 __attribute__((ext_vector_type(4)));
typedef float f32x2 __attribute__((ext_vector_type(2)));
typedef unsigned u32x4 __attribute__((ext_vector_type(4)));
typedef unsigned u32x2 __attribute__((ext_vector_type(2)));
typedef __bf16 bf16x2_t __attribute__((ext_vector_type(2)));

constexpr int DM = 2048, NTOK = 9216, NPR = 8192, SEQ = 2048, DFF = 5632;
constexpr int INW = 4352, PLD = 4096;
constexpr int DK = 128, DV = 256, NCH = 32;
constexpr float EPS = 1e-6f;
constexpr int PC_Q = 0, PC_K = 512, PC_V = 1024, PC_G = 2048, PC_U = 3072;

constexpr size_t O_Y = 0, O_SGP = 18874368, O_SPP = 19922944, O_SGS = 20045824, O_SPS = 53600256, O_END = 57532416;

constexpr size_t MiB = 1u << 20;
constexpr size_t WS_CTL = 0, CTL_ZERO_BYTES = 1 * MiB;
constexpr size_t WS_SSP = 2 * MiB;
constexpr size_t WS_GKLR = 4 * MiB;
constexpr size_t WS_DEC = 5 * MiB;
constexpr size_t WS_W = 8 * MiB, W_LAYER = 92 * MiB;
constexpr size_t WO_IN = 0, WO_OUT = 17 * MiB, WO_GU = 25 * MiB, WO_DN = 69 * MiB, WO_PL = 91 * MiB;
constexpr size_t WS_XB = 192 * MiB;
constexpr size_t WS_A2 = 228 * MiB;
constexpr size_t WS_PROJ = 264 * MiB;
constexpr size_t WS_QT = 336 * MiB, WS_KT = 344 * MiB;
constexpr size_t WS_UT = 352 * MiB;
constexpr size_t WS_ST = 416 * MiB;
constexpr size_t WS_DP = 448 * MiB;
constexpr size_t WS_ACT = 264 * MiB;
constexpr size_t WS_END = 468 * MiB;
static_assert(WS_ACT + (size_t)NTOK * DFF * 2 <= WS_ST, "ACT overlay");
static_assert(WS_DP + (size_t)4 * NTOK * 256 * 2 <= WS_END, "DP");

constexpr int CW_BAR = 4096;

constexpr int RING_BYTES = 131072, LDSCTL_OFF = RING_BYTES, MISC_OFF = LDSCTL_OFF + 320, LDS_BYTES = 147456;

__device__ __forceinline__ unsigned cvtpk(float lo, float hi) { f32x2 v = {lo, hi}; bf16x2_t b = __builtin_convertvector(v, bf16x2_t); return __builtin_bit_cast(unsigned, b); }
__device__ __forceinline__ float bf2f(unsigned short b) { return __uint_as_float((unsigned)b << 16); }
__device__ __forceinline__ float bflo(unsigned w) { return __uint_as_float(w << 16); }
__device__ __forceinline__ float bfhi(unsigned w) { return __uint_as_float(w & 0xffff0000u); }
__device__ __forceinline__ float silu_f(float x) { return x * __builtin_amdgcn_rcpf(1.0f + __builtin_amdgcn_exp2f(-1.4426950408889634f * x)); }
__device__ __forceinline__ float logsig(float x) { return fminf(x, 0.f) - log1pf(expf(-fabsf(x))); }
__device__ __forceinline__ int lane_id() { int l = __builtin_amdgcn_mbcnt_hi(~0u, __builtin_amdgcn_mbcnt_lo(~0u, 0u)); asm volatile("" : "+v"(l)); return l; }
#define LDS_WAIT() asm volatile("s_waitcnt lgkmcnt(0)" ::: "memory")
#define VM_WAIT() asm volatile("s_waitcnt vmcnt(0)" ::: "memory")
template <int CTRL> __device__ __forceinline__ float dppf(float v) { return __int_as_float(__builtin_amdgcn_update_dpp(0, __float_as_int(v), CTRL, 0xf, 0xf, true)); }
__device__ __forceinline__ float xor16_sum(float s) { auto r = __builtin_amdgcn_permlane16_swap(__float_as_uint(s), __float_as_uint(s), false, false); return __uint_as_float(r[0]) + __uint_as_float(r[1]); }
__device__ __forceinline__ float xor32_sum(float s) { auto r = __builtin_amdgcn_permlane32_swap(__float_as_uint(s), __float_as_uint(s), false, false); return __uint_as_float(r[0]) + __uint_as_float(r[1]); }
__device__ __forceinline__ float wave_sum(float v) {
    v += dppf<0xB1>(v); v += dppf<0x4E>(v); v += dppf<0x141>(v); v += dppf<0x140>(v);
    v = xor16_sum(v); return xor32_sum(v);
}

namespace pg8 {
constexpr int BM = 256, BK = 64, HALF = 128, HTB = HALF * BK * 2, STAGE_BYTES = 8 * HTB, NXCD = 8, WGM = 8;
__host__ __device__ __forceinline__ int lds_byte(int r, int c) { const int st = (r >> 4) * 2 + (c >> 5), rr = r & 15, cc = c & 31, ob = rr * 64 + cc * 2; return st * 1024 + (ob ^ (((ob >> 9) & 1) << 5)); }
__host__ __device__ __forceinline__ void stage_rc(int b, int& R, int& C) { const int st = b / 1024, sb = b % 1024, swz = sb ^ (((sb >> 9) & 1) << 5); R = (st >> 1) * 16 + swz / 64; C = (st & 1) * 32 + (swz % 64) / 2; }
__host__ __device__ __forceinline__ int perm32(int rho) { const int n = rho >> 4, i = rho & 15; return 8 * (i >> 2) + 4 * n + (i & 3); }

struct Unit { int pm, pn, bsel; };
struct Gemm { const bf16_t* A; const bf16_t* Bt; };

struct StaticOrder {
    int nM, nN, nwg, G, c;
    __device__ void init(int M, int N, int G_, int c_) { nM = M / BM; nN = N / BM; nwg = nM * nN; G = G_; c = c_; }
    __device__ bool next(int i, Unit& u) const {
        const long L = (long)i * G + c; if (L >= nwg) return false;
        int wgid = (int)L; { const int q = nwg / NXCD, r = nwg % NXCD, xcd = wgid % NXCD, off = wgid / NXCD; wgid = (xcd < r ? xcd * (q + 1) : r * (q + 1) + (xcd - r) * q) + off; }
        const int nig = WGM * nN, gid = wgid / nig, fm = gid * WGM, gsz = (nM - fm) < WGM ? (nM - fm) : WGM;
        u.pm = fm + ((wgid % nig) % gsz); u.pn = (wgid % nig) / gsz; u.bsel = 0; return true;
    }
};
struct PoolOrder {
    int G, c;
    __device__ bool next(int i, Unit& u) const { const int L = i * G + c; if (L >= 144) return false; u.pm = L; u.pn = 0; u.bsel = L / 36; return true; }
};

template <class Epi, class Sched, int LDA, int LDB, int K, int BSEL>
__device__ __forceinline__ void gemm_phase(LAS unsigned char* lds, const Gemm g, const Sched& S, const Epi& E, int wid) {
    const int lane = lane_id(), tid = wid * 64 + lane, wr = wid >> 2, wc = wid & 3, fr = lane & 15, fq = lane >> 4;
    constexpr int nt = K / BK;
    unsigned voffA[2], voffB[2];
#pragma unroll
    for (int i = 0; i < 2; ++i) { int R, C; stage_rc(tid * 16 + i * 8192, R, C); const int Rb = Epi::PERM ? ((R & ~31) + perm32(R & 31)) : R;
        voffA[i] = (unsigned)(R * LDA + C) * 2u; voffB[i] = (unsigned)(Rb * LDB + C) * 2u; }
    constexpr size_t kstep = (size_t)(BK * 2);
    constexpr size_t hstA = (size_t)HALF * LDA * 2, hstB = (size_t)HALF * LDB * 2;
    constexpr size_t tstA = 2 * hstA, tstB = 2 * hstB;
    const unsigned ldsw = (unsigned)wid * 1024u;
    const int aoff = lds_byte(wr * 64 + fr, fq * 8), boff = lds_byte(wc * 32 + fr, fq * 8);
#define PG8_SA(b, h) (((b) * 2 + (h)) * HTB)
#define PG8_SB(b, h) ((4 + (b) * 2 + (h)) * HTB)
#define PG8_STAGE(bufoff, gbase, voff) do { _Pragma("unroll") for (int _i = 0; _i < 2; ++_i) \
        __builtin_amdgcn_global_load_lds((const unsigned*)((const char*)(gbase) + (voff)[_i]), (LAS unsigned*)(lds + (bufoff) + ldsw + _i * 8192), 16, 0, 0); } while (0)
#define PG8_LDA(dst, b, h) do { _Pragma("unroll") for (int m = 0; m < 4; ++m) _Pragma("unroll") for (int k = 0; k < 2; ++k) dst[m][k] = *(const LAS bf16x8*)(lds + PG8_SA(b, h) + aoff + m * 2048 + k * 1024); } while (0)
#define PG8_LDB(dst, b, h) do { _Pragma("unroll") for (int n = 0; n < 2; ++n) _Pragma("unroll") for (int k = 0; k < 2; ++k) dst[n][k] = *(const LAS bf16x8*)(lds + PG8_SB(b, h) + boff + n * 2048 + k * 1024); } while (0)
#define PG8_MMA(ai, bj, At, Bt) do { __builtin_amdgcn_s_setprio(1); _Pragma("unroll") for (int m = 0; m < 4; ++m) _Pragma("unroll") for (int n = 0; n < 2; ++n) _Pragma("unroll") for (int k = 0; k < 2; ++k) \
        acc[ai][bj][m][n] = __builtin_amdgcn_mfma_f32_16x16x32_bf16(Bt[n][k], At[m][k], acc[ai][bj][m][n], 0, 0, 0); __builtin_amdgcn_s_setprio(0); } while (0)
#define PG8_WAIT_V(n) asm volatile("s_waitcnt vmcnt(" #n ")" ::: "memory")
#define PG8_WAIT_L(n) asm volatile("s_waitcnt lgkmcnt(" #n ")" ::: "memory")
#define PG8_BAR __builtin_amdgcn_s_barrier()
#define PG8_SCHED __builtin_amdgcn_sched_barrier(0)
    Unit cur, nxt; int ui = 0;
    if (!S.next(0, cur)) return;
    f32x4 acc[2][2][4][2];
#pragma unroll
    for (int a = 0; a < 2; ++a)
#pragma unroll
        for (int b = 0; b < 2; ++b)
#pragma unroll
            for (int m = 0; m < 4; ++m)
#pragma unroll
                for (int n = 0; n < 2; ++n) acc[a][b][m][n] = (f32x4){0.f, 0.f, 0.f, 0.f};
    bf16x8 At[4][2], B0[2][2], B1[2][2];
    const char* cA = (const char*)g.A + (size_t)cur.pm * tstA; const char* cB = (const char*)g.Bt + (size_t)cur.pn * tstB + (size_t)cur.bsel * BSEL;
    PG8_STAGE(PG8_SB(0, 0), cB, voffB); PG8_STAGE(PG8_SB(0, 1), cB + hstB, voffB); PG8_STAGE(PG8_SA(0, 0), cA, voffA); PG8_STAGE(PG8_SA(0, 1), cA + hstA, voffA);
    if (wr == 1) PG8_BAR;
    PG8_WAIT_V(2); PG8_BAR;
    PG8_STAGE(PG8_SB(1, 0), cB + kstep, voffB); PG8_STAGE(PG8_SA(1, 0), cA + kstep, voffA); PG8_STAGE(PG8_SB(1, 1), cB + hstB + kstep, voffB);
    PG8_WAIT_V(6); PG8_BAR;
    for (;;) {
        const bool has_next = S.next(ui + 1, nxt);
        const char* nA = has_next ? (const char*)g.A + (size_t)nxt.pm * tstA : cA;
        const char* nB = has_next ? (const char*)g.Bt + (size_t)nxt.pn * tstB + (size_t)nxt.bsel * BSEL : cB;
#pragma unroll 1
        for (int t = 0; t < nt; t += 2) {
            const bool last = (t == nt - 2);
            const char* a1 = cA + (size_t)(t + 1) * kstep;
            const char* a2 = last ? nA : cA + (size_t)(t + 2) * kstep; const char* b2 = last ? nB : cB + (size_t)(t + 2) * kstep;
            const char* a3 = a2 + kstep; const char* b3 = b2 + kstep;
            PG8_LDB(B0, 0, 0); PG8_LDB(B1, 0, 1); PG8_SCHED; PG8_LDA(At, 0, 0); PG8_STAGE(PG8_SA(1, 1), a1 + hstA, voffA);
            PG8_WAIT_V(8); PG8_WAIT_L(0); PG8_BAR; PG8_MMA(0, 0, At, B0); PG8_MMA(0, 1, At, B1); PG8_BAR; PG8_SCHED;
            PG8_LDA(At, 0, 1); PG8_STAGE(PG8_SB(0, 0), b2, voffB); PG8_STAGE(PG8_SB(0, 1), b2 + hstB, voffB); PG8_STAGE(PG8_SA(0, 0), a2, voffA);
            PG8_WAIT_V(8); PG8_WAIT_L(0); PG8_BAR; PG8_MMA(1, 0, At, B0); PG8_MMA(1, 1, At, B1); PG8_BAR; PG8_SCHED;
            PG8_LDB(B0, 1, 0); PG8_LDB(B1, 1, 1); PG8_SCHED; PG8_LDA(At, 1, 0); PG8_STAGE(PG8_SA(0, 1), a2 + hstA, voffA);
            PG8_WAIT_V(8); PG8_WAIT_L(0); PG8_BAR; PG8_MMA(0, 0, At, B0); PG8_MMA(0, 1, At, B1); PG8_BAR; PG8_SCHED;
            PG8_LDA(At, 1, 1); PG8_STAGE(PG8_SB(1, 0), b3, voffB); PG8_STAGE(PG8_SB(1, 1), b3 + hstB, voffB); PG8_STAGE(PG8_SA(1, 0), a3, voffA);
            PG8_WAIT_V(8); PG8_WAIT_L(0); PG8_BAR; PG8_MMA(1, 0, At, B0); PG8_MMA(1, 1, At, B1); PG8_BAR; PG8_SCHED;
        }
        if (wr == 0) PG8_BAR;
        E(acc, cur, wr, wc, fr, fq);
        if (!has_next) break;
#pragma unroll
        for (int a = 0; a < 2; ++a)
#pragma unroll
            for (int b = 0; b < 2; ++b)
#pragma unroll
                for (int m = 0; m < 4; ++m)
#pragma unroll
                    for (int n = 0; n < 2; ++n) acc[a][b][m][n] = (f32x4){0.f, 0.f, 0.f, 0.f};
        cur = nxt; cA = nA; cB = nB; ++ui;
        if (wr == 1) PG8_BAR;
    }
    PG8_WAIT_V(0);
    PG8_BAR;
#undef PG8_SA
#undef PG8_SB
#undef PG8_STAGE
#undef PG8_LDA
#undef PG8_LDB
#undef PG8_MMA
#undef PG8_WAIT_V
#undef PG8_WAIT_L
#undef PG8_BAR
#undef PG8_SCHED
}

__device__ __forceinline__ void load_rscale(const float* ssp, int row0, int fq, float (&rs)[2][4]) {
#pragma unroll
    for (int ai = 0; ai < 2; ++ai)
#pragma unroll
        for (int m = 0; m < 4; ++m) {
            const f32x4* p = (const f32x4*)(ssp + (size_t)(row0 + ai * HALF + m * 16) * 32 + fq * 8);
            const f32x4 a = p[0], b = p[1];
            float s = ((a.x + a.y) + (a.z + a.w)) + ((b.x + b.y) + (b.z + b.w));
            s = xor16_sum(s); s = xor32_sum(s);
            rs[ai][m] = rsqrtf(s * (1.0f / DM) + EPS);
        }
}
struct EpiInProj {
    static constexpr bool PERM = true;
    bf16_t* proj; float* gklr; const float* ssp;
    __device__ __forceinline__ void operator()(const f32x4 (&acc)[2][2][4][2], const Unit& u, int wr, int wc, int fr, int fq) const {
        const int row0 = u.pm * BM + wr * 64 + fr;
        float rs[2][4]; load_rscale(ssp, row0, fq, rs);
        if (u.pn < 16) {
            const int col0 = u.pn * BM + wc * 32 + 8 * fq;
#pragma unroll
            for (int ai = 0; ai < 2; ++ai)
#pragma unroll
                for (int m = 0; m < 4; ++m) { bf16_t* rowp = proj + (size_t)(row0 + ai * HALF + m * 16) * PLD + col0; const float s = rs[ai][m];
#pragma unroll
                    for (int bj = 0; bj < 2; ++bj) { const f32x4 v0 = acc[ai][bj][m][0] * s, v1 = acc[ai][bj][m][1] * s;
                        u32x4 w; w.x = cvtpk(v0[0], v0[1]); w.y = cvtpk(v0[2], v0[3]); w.z = cvtpk(v1[0], v1[1]); w.w = cvtpk(v1[2], v1[3]);
                        *(u32x4*)(rowp + bj * HALF) = w; } }
        } else if (wc == 0 && fq < 2) {
#pragma unroll
            for (int ai = 0; ai < 2; ++ai)
#pragma unroll
                for (int m = 0; m < 4; ++m) { float* gp = gklr + (size_t)(row0 + ai * HALF + m * 16) * 16 + 8 * fq; const float s = rs[ai][m];
                    *(f32x4*)(gp) = acc[ai][0][m][0] * s; *(f32x4*)(gp + 4) = acc[ai][0][m][1] * s; }
        }
    }
};
struct EpiResid {
    static constexpr bool PERM = false;
    const float* base_p; const float* base_s; float* X; bf16_t* xb; float* ssp;
    __device__ __forceinline__ void operator()(const f32x4 (&acc)[2][2][4][2], const Unit& u, int wr, int wc, int fr, int fq) const {
        const int row0 = u.pm * BM + wr * 64 + fr, col0 = u.pn * BM + wc * 32 + 4 * fq;
        const float* base = (u.pm < NPR / BM) ? base_p : base_s;
#pragma unroll
        for (int ai = 0; ai < 2; ++ai)
#pragma unroll
            for (int m = 0; m < 4; ++m) { const int row = row0 + ai * HALF + m * 16; const size_t off = (size_t)row * DM + col0; float ss = 0.f;
#pragma unroll
                for (int bj = 0; bj < 2; ++bj)
#pragma unroll
                    for (int n = 0; n < 2; ++n) { const f32x4 bs = *(const f32x4*)(base + off + bj * HALF + n * 16); const f32x4 o = bs + acc[ai][bj][m][n];
                        *(f32x4*)(X + off + bj * HALF + n * 16) = o; ss += (o[0] * o[0] + o[1] * o[1]) + (o[2] * o[2] + o[3] * o[3]);
                        u32x2 w; w.x = cvtpk(o[0], o[1]); w.y = cvtpk(o[2], o[3]); *(u32x2*)(xb + off + bj * HALF + n * 16) = w; }
                ss = xor16_sum(ss); ss = xor32_sum(ss);
                if (fq == 0) ssp[(size_t)row * 32 + u.pn * 4 + wc] = ss;
                asm volatile("" ::: "memory"); }
    }
};
struct EpiGateUp {
    static constexpr bool PERM = true;
    bf16_t* act; const float* ssp;
    __device__ __forceinline__ void operator()(const f32x4 (&acc)[2][2][4][2], const Unit& u, int wr, int wc, int fr, int fq) const {
        const int row0 = u.pm * BM + wr * 64 + fr, col0 = u.pn * HALF + wc * 32 + 8 * fq;
        float rs[2][4]; load_rscale(ssp, row0, fq, rs);
#pragma unroll
        for (int ai = 0; ai < 2; ++ai)
#pragma unroll
            for (int m = 0; m < 4; ++m) { const float s = rs[ai][m]; float a[8];
#pragma unroll
                for (int n = 0; n < 2; ++n)
#pragma unroll
                    for (int e = 0; e < 4; ++e) { const float gt = acc[ai][0][m][n][e] * s, up = acc[ai][1][m][n][e] * s; a[n * 4 + e] = silu_f(gt) * up; }
                u32x4 w; w.x = cvtpk(a[0], a[1]); w.y = cvtpk(a[2], a[3]); w.z = cvtpk(a[4], a[5]); w.w = cvtpk(a[6], a[7]);
                *(u32x4*)(act + (size_t)(row0 + ai * HALF + m * 16) * DFF + col0) = w; }
    }
};
struct EpiPool {
    static constexpr bool PERM = true;
    bf16_t* a2; const float* pscale;
    __device__ __forceinline__ void operator()(const f32x4 (&acc)[2][2][4][2], const Unit& u, int wr, int wc, int fr, int fq) const {
        const int gi = u.pm / 36, tile = u.pm - gi * 36;
        const int row0 = tile * BM + wr * 64 + fr, col0 = gi * 256 + wc * 32 + 8 * fq;
        f32x4 sc[2][2];
#pragma unroll
        for (int bj = 0; bj < 2; ++bj)
#pragma unroll
            for (int n = 0; n < 2; ++n) sc[bj][n] = *(const f32x4*)(pscale + col0 + bj * HALF + 4 * n);
#pragma unroll
        for (int ai = 0; ai < 2; ++ai)
#pragma unroll
            for (int m = 0; m < 4; ++m) { bf16_t* rowp = a2 + (size_t)(row0 + ai * HALF + m * 16) * DM + 1024 + col0;
#pragma unroll
                for (int bj = 0; bj < 2; ++bj) { const f32x4 v0 = acc[ai][bj][m][0] * sc[bj][0], v1 = acc[ai][bj][m][1] * sc[bj][1];
                    u32x4 w; w.x = cvtpk(v0[0], v0[1]); w.y = cvtpk(v0[2], v0[3]); w.z = cvtpk(v1[0], v1[1]); w.w = cvtpk(v1[2], v1[3]);
                    *(u32x4*)(rowp + bj * HALF) = w; } }
    }
};
}

typedef GAS unsigned gu32;
#define RLX_AGENT __ATOMIC_RELAXED, __HIP_MEMORY_SCOPE_AGENT
#define XB_TMO      128
#define XB_XCNT(j)  (256  + 64 * (j))
#define XB_XSUB(j)  (1280 + 64 * (j))
#define XB_XGEN(j)  (2304 + 64 * (j))
#define XB_TOP      3328
#define XB_TOPGEN   3392
#define XCD_BAR_WORDS 3456
#define XB_SPIN_CAP (1u << 18)
__device__ __forceinline__ unsigned xb_ld(unsigned* p)              { return __hip_atomic_load(p, __ATOMIC_RELAXED, __HIP_MEMORY_SCOPE_AGENT); }
__device__ __forceinline__ unsigned xb_add(unsigned* p, unsigned v) { return __hip_atomic_fetch_add(p, v, __ATOMIC_RELAXED, __HIP_MEMORY_SCOPE_AGENT); }
__device__ __forceinline__ unsigned xb_xcc_id() { return (unsigned)__builtin_amdgcn_s_getreg((3 << 11) | 20) & 0xFu; }
#define XB_SPIN(cond, bar) do { unsigned _sp = 0; while (cond) { __builtin_amdgcn_s_sleep(1); \
    if ((++_sp & 255u) == 0u) { if (xb_ld(&(bar)[XB_TMO])) break; if (_sp > XB_SPIN_CAP) { atomicAdd(&(bar)[XB_TMO], 1u); break; } } } } while (0)
struct XcdBarrier { unsigned* bar; unsigned x; volatile LAS unsigned* st; };
__device__ __forceinline__ XcdBarrier xcd_barrier_post(unsigned* bar, volatile LAS unsigned* st) {
    XcdBarrier b; b.bar = bar; b.x = xb_xcc_id(); b.st = st;
    if (threadIdx.x == 0) (void)xb_add(&bar[XB_XCNT(b.x)], 1u);
    return b;
}
__device__ __forceinline__ void xcd_barrier_complete(unsigned* bar, unsigned x, unsigned& nloc, unsigned& nx) {
    const unsigned G = gridDim.x * gridDim.y * gridDim.z;
    unsigned sum, cnt, mine, sp = 0u;
    for (;;) {
        sum = 0u; cnt = 0u; mine = 0u;
#pragma unroll
        for (unsigned j = 0; j < 16; ++j) { const unsigned c = xb_ld(&bar[XB_XCNT(j)]); sum += c; cnt += (c > 0u) ? 1u : 0u; mine = (j == x) ? c : mine; }
        if (sum == G) break;
        __builtin_amdgcn_s_sleep(1);
        if ((++sp & 255u) == 0u) { if (xb_ld(&bar[XB_TMO])) break; if (sp > XB_SPIN_CAP) { atomicAdd(&bar[XB_TMO], 1u); break; } }
    }
    nloc = mine > 0u ? mine : 1u; nx = cnt > 0u ? cnt : 1u;
}
__device__ __forceinline__ void xcd_barrier(const XcdBarrier& b) {
    asm volatile("s_waitcnt vmcnt(0)" ::: "memory");
    __syncthreads();
    if (threadIdx.x == 0) {
        unsigned* bar = b.bar; unsigned bxid = b.x; asm volatile("" : "+s"(bar), "+s"(bxid));
        __builtin_amdgcn_s_waitcnt(0);
        unsigned nloc = b.st[0], nx = b.st[1];
        if (nloc == 0u) { xcd_barrier_complete(bar, bxid, nloc, nx); b.st[0] = nloc; b.st[1] = nx; }
        const unsigned old = xb_add(&bar[XB_XSUB(bxid)], 1u);
        const unsigned gen = old / nloc;
        if (old + 1u == (gen + 1u) * nloc) {
            __builtin_amdgcn_fence(__ATOMIC_RELEASE, "agent");
            asm volatile("s_waitcnt vmcnt(0)" ::: "memory");
            const unsigned og = xb_add(&bar[XB_TOP], 1u);
            const unsigned tg = og / nx;
            if (og + 1u == (tg + 1u) * nx) xb_add(&bar[XB_TOPGEN], 1u);
            else XB_SPIN(xb_ld(&bar[XB_TOPGEN]) == tg, bar);
            __builtin_amdgcn_fence(__ATOMIC_ACQUIRE, "agent");
            xb_add(&bar[XB_XGEN(bxid)], 1u);
            asm volatile("s_waitcnt vmcnt(0)" ::: "memory");
        } else {
            XB_SPIN(xb_ld(&bar[XB_XGEN(bxid)]) == gen, bar);
            __builtin_amdgcn_fence(__ATOMIC_ACQUIRE, "agent");
            asm volatile("s_waitcnt vmcnt(0)" ::: "memory");
        }
    }
    __syncthreads();
}

struct Args { const float* in[17]; float* out; unsigned char* ws; };
enum { I_XP = 0, I_XS, I_SG, I_SP, I_NMIX, I_WIN, I_WGK, I_BGK, I_GNORM, I_WPOOL, I_PSCALE, I_WOUT, I_NFFN, I_WGATE, I_WUP, I_WDOWN, I_NFIN };

__device__ __forceinline__ void transpose_item(const float* src, int ld, int nvalid, const float* kscale, float cscale, bf16_t* dst, int K, int k0, LAS float* scr, int lane) {
    const int c = lane & 31;
#pragma unroll 8
    for (int i = 0; i < 32; ++i) { const int kk = 2 * i + (lane >> 5); float v = 0.f;
        if (c < nvalid) { v = src[(size_t)(k0 + kk) * ld + c]; const float ks = kscale ? kscale[k0 + kk] : 1.f; v *= ks * cscale; }
        scr[kk * 33 + c] = v; }
    LDS_WAIT(); asm volatile("" ::: "memory");
    const int ch = lane & 7;
#pragma unroll
    for (int j = 0; j < 4; ++j) { const int n = (lane >> 3) + 8 * j; const LAS float* s = scr + (8 * ch) * 33 + n;
        u32x4 o; o.x = cvtpk(s[0 * 33], s[1 * 33]); o.y = cvtpk(s[2 * 33], s[3 * 33]); o.z = cvtpk(s[4 * 33], s[5 * 33]); o.w = cvtpk(s[6 * 33], s[7 * 33]);
        *(u32x4*)(dst + (size_t)n * K + k0 + 8 * ch) = o; }
    LDS_WAIT(); asm volatile("" ::: "memory");
}
constexpr int IT_IN = 32 * 136, IT_OUT = 32 * 64, IT_GU = 32 * 352, IT_DN = 88 * 64, IT_PL = 4 * 4 * 8, IT_LAYER = IT_IN + IT_OUT + IT_GU + IT_DN + IT_PL;
__device__ __forceinline__ void p0_prologue(const Args& a, LAS unsigned char* lds, int gw, int NGW, int wave) {
    const int lane = lane_id();
    LAS float* scr = (LAS float*)(lds + wave * 16384);
    for (int it = gw; it < 2 * IT_LAYER; it += NGW) {
        const int l = it / IT_LAYER; int r = it - l * IT_LAYER;
        unsigned char* wl = a.ws + WS_W + (size_t)l * W_LAYER;
        if (r < IT_IN) { const int kb = r / 136, nb = r - kb * 136, n0 = nb * 32;
            int sc, nv; if (n0 < 3072) { sc = n0; nv = 32; } else if (n0 < 4096) { sc = n0 + 16; nv = 32; } else if (n0 == 4096) { sc = 3072; nv = 16; } else { sc = 0; nv = 0; }
            transpose_item(a.in[I_WIN] + (size_t)l * DM * 4112 + sc, 4112, nv, a.in[I_NMIX] + l * DM, n0 < 512 ? 0.08838834764831845f : 1.f,
                           (bf16_t*)(wl + WO_IN) + (size_t)n0 * DM, DM, kb * 64, scr, lane); continue; } r -= IT_IN;
        if (r < IT_OUT) { const int kb = r / 64, nb = r - kb * 64, n0 = nb * 32;
            transpose_item(a.in[I_WOUT] + (size_t)l * DM * DM + n0, DM, 32, nullptr, 1.f, (bf16_t*)(wl + WO_OUT) + (size_t)n0 * DM, DM, kb * 64, scr, lane); continue; } r -= IT_OUT;
        if (r < IT_GU) { const int kb = r / 352, nb = r - kb * 352, n0 = nb * 32, t = n0 >> 8, rr = n0 & 255;
            const float* src = (rr < 128 ? a.in[I_WGATE] : a.in[I_WUP]) + (size_t)l * DM * DFF + 128 * t + (rr & 127);
            transpose_item(src, DFF, 32, a.in[I_NFFN] + l * DM, 1.f, (bf16_t*)(wl + WO_GU) + (size_t)n0 * DM, DM, kb * 64, scr, lane); continue; } r -= IT_GU;
        if (r < IT_DN) { const int kb = r / 64, nb = r - kb * 64, n0 = nb * 32;
            transpose_item(a.in[I_WDOWN] + (size_t)l * DFF * DM + n0, DM, 32, nullptr, 1.f, (bf16_t*)(wl + WO_DN) + (size_t)n0 * DFF, DFF, kb * 64, scr, lane); continue; } r -= IT_DN;
        { const int gi = r >> 5, q = r & 31, kb = q >> 3, nb = q & 7, n0 = nb * 32;
            transpose_item(a.in[I_WPOOL] + ((size_t)l * 4 + gi) * 65536 + n0, 256, 32, nullptr, 1.f, (bf16_t*)(wl + WO_PL) + (size_t)gi * 65536 + (size_t)n0 * 256, 256, kb * 64, scr, lane); }
    }
    bf16_t* xb = (bf16_t*)(a.ws + WS_XB); float* ssp = (float*)(a.ws + WS_SSP);
    for (int m = gw; m < NTOK; m += NGW) {
        const float* xr = (m < NPR) ? a.in[I_XP] + (size_t)m * DM : a.in[I_XS] + (size_t)(m - NPR) * DM;
        float ss = 0.f;
#pragma unroll
        for (int j = 0; j < 8; ++j) { const f32x4 v = ((const f32x4*)xr)[lane + 64 * j]; ss += (v.x * v.x + v.y * v.y) + (v.z * v.z + v.w * v.w);
            u32x2 w; w.x = cvtpk(v.x, v.y); w.y = cvtpk(v.z, v.w); ((u32x2*)(xb + (size_t)m * DM))[lane + 64 * j] = w; }
        ss = wave_sum(ss);
        if (lane < 32) ssp[(size_t)m * 32 + lane] = (lane == 0) ? ss : 0.f;
    }
}

__device__ __forceinline__ void gla_a_unit(const Args& a, int l, int unit, LAS unsigned char* lds, int wave) {
    const int lane = lane_id(), tid = wave * 64 + lane;
    const int bh = unit >> 5, c = unit & 31, b = bh >> 2, h = bh & 3, tok0 = b * SEQ + c * 64;
    const bf16_t* proj = (const bf16_t*)(a.ws + WS_PROJ); const float* gklr = (const float*)(a.ws + WS_GKLR);
    bf16_t* QT = (bf16_t*)(a.ws + WS_QT); bf16_t* KT = (bf16_t*)(a.ws + WS_KT); float* DEC = (float*)(a.ws + WS_DEC); float* UT = (float*)(a.ws + WS_UT);
    LAS float* Lgk = (LAS float*)(lds);
    LAS float* Lseg = (LAS float*)(lds + 4096);
    LAS bf16_t* Lkd = (LAS bf16_t*)(lds + 8192);
    LAS bf16_t* Lv = (LAS bf16_t*)(lds + 32768);
    if (tid < 256) ((LAS f32x4*)Lgk)[tid] = ((const f32x4*)(gklr + (size_t)tok0 * 16))[tid];
#pragma unroll
    for (int i = 0; i < 4; ++i) { const int p = tid + 512 * i, t = p >> 5, c16 = p & 31;
        const u32x4 v = *(const u32x4*)(proj + (size_t)(tok0 + t) * PLD + PC_V + h * DV + c16 * 8);
        LAS u32x2* d = (LAS u32x2*)(Lv + t * 260 + c16 * 8); d[0] = (u32x2){v.x, v.y}; d[1] = (u32x2){v.z, v.w}; }
    const int d = tid & 127, tq = tid >> 7;
    float w[16];
#pragma unroll
    for (int r = 0; r < 16; ++r) w[r] = a.in[I_WGK][(size_t)l * 16 * 512 + r * 512 + h * DK + d];
    const float bias = a.in[I_BGK][l * 512 + h * DK + d];
    unsigned short qv[16], kv[16];
#pragma unroll
    for (int i = 0; i < 16; ++i) { const size_t ro = (size_t)(tok0 + tq * 16 + i) * PLD + h * DK + d; qv[i] = proj[ro + PC_Q]; kv[i] = proj[ro + PC_K]; }
    __syncthreads();
    float bb[16]; float run = 0.f;
#pragma unroll
    for (int i = 0; i < 16; ++i) { const LAS f32x4* gp = (const LAS f32x4*)(Lgk + (tq * 16 + i) * 16); float x = bias;
#pragma unroll
        for (int r4 = 0; r4 < 4; ++r4) { const f32x4 g4 = gp[r4]; x += g4.x * w[4 * r4] + g4.y * w[4 * r4 + 1] + g4.z * w[4 * r4 + 2] + g4.w * w[4 * r4 + 3]; }
        run += logsig(x) * 0.0625f; bb[i] = run; }
    Lseg[tq * 128 + d] = run;
    __syncthreads();
    float off = 0.f, tot = 0.f;
#pragma unroll
    for (int q = 0; q < 4; ++q) { const float s = Lseg[q * 128 + d]; tot += s; if (q < tq) off += s; }
    unsigned kdp[8];
#pragma unroll
    for (int i = 0; i < 16; i += 2) { float kd2[2];
#pragma unroll
        for (int e = 0; e < 2; ++e) { const float bc = bb[i + e] + off, q = bf2f(qv[i + e]), k = bf2f(kv[i + e]);
            const size_t o = (size_t)(unit * 64 + tq * 16 + i + e) * DK + d;
            QT[o] = (bf16_t)(cvtpk(q * __expf(bc), 0.f) & 0xffffu); KT[o] = (bf16_t)(cvtpk(k * __expf(-bc), 0.f) & 0xffffu); kd2[e] = k * __expf(tot - bc); }
        kdp[i >> 1] = cvtpk(kd2[0], kd2[1]); }
    { LAS u32x4* kp = (LAS u32x4*)(Lkd + d * 72 + tq * 16); kp[0] = (u32x4){kdp[0], kdp[1], kdp[2], kdp[3]}; kp[1] = (u32x4){kdp[4], kdp[5], kdp[6], kdp[7]}; }
    if (tq == 0) DEC[(size_t)unit * DK + d] = __expf(tot);
    __syncthreads();
    const int dv0 = wave * 32, lr = lane & 15, lq = lane >> 4;
    bf16x8 vf[2][2];
#pragma unroll
    for (int mt = 0; mt < 2; ++mt)
#pragma unroll
        for (int ks = 0; ks < 2; ++ks)
#pragma unroll
            for (int j = 0; j < 8; ++j) vf[mt][ks][j] = (short)Lv[(ks * 32 + 8 * lq + j) * 260 + dv0 + mt * 16 + lr];
#pragma unroll
    for (int nt = 0; nt < 8; ++nt) {
        bf16x8 kf[2];
#pragma unroll
        for (int ks = 0; ks < 2; ++ks) kf[ks] = *(const LAS bf16x8*)(Lkd + (nt * 16 + lr) * 72 + ks * 32 + 8 * lq);
#pragma unroll
        for (int mt = 0; mt < 2; ++mt) { f32x4 acc = {0.f, 0.f, 0.f, 0.f};
#pragma unroll
            for (int ks = 0; ks < 2; ++ks) acc = __builtin_amdgcn_mfma_f32_16x16x32_bf16(kf[ks], vf[mt][ks], acc, 0, 0, 0);
            *(f32x4*)(UT + ((size_t)unit * DV + dv0 + mt * 16 + lr) * DK + nt * 16 + lq * 4) = acc; }
    }
    __syncthreads();
}

__device__ __forceinline__ void gla_sample_unit(const Args& a, int l, int unit, LAS unsigned char* lds, int wave) {
    const int lane = lane_id(), tid = wave * 64 + lane;
    const int b = unit >> 2, h = unit & 3, row0 = NPR + b * 8;
    const bf16_t* proj = (const bf16_t*)(a.ws + WS_PROJ); const float* gklr = (const float*)(a.ws + WS_GKLR); bf16_t* A2 = (bf16_t*)(a.ws + WS_A2);
    LAS float* Lgk = (LAS float*)(lds);
    LAS float* Lqt = (LAS float*)(lds + 1024);
    LAS float* Lkt = (LAS float*)(lds + 5120);
    LAS float* Lkd = (LAS float*)(lds + 9216);
    LAS float* Ldec = (LAS float*)(lds + 13312);
    LAS float* Lsc = (LAS float*)(lds + 13824);
    LAS float* Lo = (LAS float*)(lds + 16384);
    LAS float* Lv = (LAS float*)(lds + 81920);
    if (tid < 32) ((LAS f32x4*)Lgk)[tid] = ((const f32x4*)(gklr + (size_t)row0 * 16))[tid];
    __syncthreads();
    if (tid < 128) {
        const int d = tid; float w[16];
#pragma unroll
        for (int r = 0; r < 16; ++r) w[r] = a.in[I_WGK][(size_t)l * 16 * 512 + r * 512 + h * DK + d];
        const float bias = a.in[I_BGK][l * 512 + h * DK + d];
        float bb[8]; float run = 0.f;
#pragma unroll
        for (int t = 0; t < 8; ++t) { float x = bias;
#pragma unroll
            for (int r = 0; r < 16; ++r) x += Lgk[t * 16 + r] * w[r];
            run += logsig(x) * 0.0625f; bb[t] = run; }
#pragma unroll
        for (int t = 0; t < 8; ++t) { const size_t ro = (size_t)(row0 + t) * PLD + h * DK + d; const float q = bf2f(proj[ro + PC_Q]), k = bf2f(proj[ro + PC_K]);
            Lqt[d * 8 + t] = q * __expf(bb[t]); Lkt[t * 128 + d] = k * __expf(-bb[t]); Lkd[d * 8 + t] = k * __expf(run - bb[t]); }
        Ldec[d] = __expf(run);
    }
    __syncthreads();
    if (tid < 64) { const int i = tid >> 3, j = tid & 7; float s = 0.f;
        if (j <= i) for (int d = 0; d < 128; ++d) s += Lqt[d * 8 + i] * Lkt[j * 128 + d];
        Lsc[i * 8 + j] = s; }
    const int dv4 = lane * 4;
    f32x4 v[8];
#pragma unroll
    for (int t = 0; t < 8; ++t) { const u32x2 p = *(const u32x2*)(proj + (size_t)(row0 + t) * PLD + PC_V + h * DV + dv4); v[t] = (f32x4){bflo(p.x), bfhi(p.x), bflo(p.y), bfhi(p.y)}; }
    if (wave == 0) {
#pragma unroll
        for (int t = 0; t < 8; ++t) *(LAS f32x4*)(Lv + t * 256 + dv4) = v[t]; }
    const float* s0p = a.in[I_SG] + ((((size_t)l * 128 + b) * 4 + h) * DK) * DV;
    float* snp = a.out + O_SGS + ((((size_t)l * 128 + b) * 4 + h) * DK) * DV;
    f32x4 op[8];
#pragma unroll
    for (int t = 0; t < 8; ++t) op[t] = (f32x4){0.f, 0.f, 0.f, 0.f};
#pragma unroll 4
    for (int i = 0; i < 16; ++i) { const int dk = wave * 16 + i;
        const f32x4 s0 = *(const f32x4*)(s0p + (size_t)dk * DV + dv4);
        const f32x4 qa = *(const LAS f32x4*)(Lqt + dk * 8), qb = *(const LAS f32x4*)(Lqt + dk * 8 + 4);
        const f32x4 ka = *(const LAS f32x4*)(Lkd + dk * 8), kb = *(const LAS f32x4*)(Lkd + dk * 8 + 4);
        f32x4 sn = s0 * Ldec[dk];
        op[0] += qa.x * s0; op[1] += qa.y * s0; op[2] += qa.z * s0; op[3] += qa.w * s0; op[4] += qb.x * s0; op[5] += qb.y * s0; op[6] += qb.z * s0; op[7] += qb.w * s0;
        sn += ka.x * v[0]; sn += ka.y * v[1]; sn += ka.z * v[2]; sn += ka.w * v[3]; sn += kb.x * v[4]; sn += kb.y * v[5]; sn += kb.z * v[6]; sn += kb.w * v[7];
        *(f32x4*)(snp + (size_t)dk * DV + dv4) = sn; }
#pragma unroll
    for (int t = 0; t < 8; ++t) *(LAS f32x4*)(Lo + (wave * 8 + t) * 256 + dv4) = op[t];
    __syncthreads();
    { const int t = wave; f32x4 o = {0.f, 0.f, 0.f, 0.f};
#pragma unroll
        for (int w8 = 0; w8 < 8; ++w8) o += *(const LAS f32x4*)(Lo + (w8 * 8 + t) * 256 + dv4);
        for (int j = 0; j <= t; ++j) o += Lsc[t * 8 + j] * *(const LAS f32x4*)(Lv + j * 256 + dv4);
        float ss = (o.x * o.x + o.y * o.y) + (o.z * o.z + o.w * o.w); ss = wave_sum(ss);
        const float r = rsqrtf(ss * (1.0f / DV) + EPS);
        const u32x2 gp = *(const u32x2*)(proj + (size_t)(row0 + t) * PLD + PC_G + h * DV + dv4);
        const f32x4 gn = *(const f32x4*)(a.in[I_GNORM] + l * DV + dv4);
        const float o0 = o.x * r * gn.x * silu_f(bflo(gp.x)), o1 = o.y * r * gn.y * silu_f(bfhi(gp.x)), o2 = o.z * r * gn.z * silu_f(bflo(gp.y)), o3 = o.w * r * gn.w * silu_f(bfhi(gp.y));
        u32x2 w; w.x = cvtpk(o0, o1); w.y = cvtpk(o2, o3); *(u32x2*)(A2 + (size_t)(row0 + t) * DM + h * DV + dv4) = w; }
    __syncthreads();
}

__device__ __forceinline__ void pool_d_phase(const Args& a, int l, int NT, int bx, int wave) {
    const int gtid = bx * 512 + wave * 64 + lane_id();
    const bf16_t* proj = (const bf16_t*)(a.ws + WS_PROJ); bf16_t* DP = (bf16_t*)(a.ws + WS_DP);
    const float* spool = a.in[I_SP] + (size_t)l * 128 * 15 * 1024;
    for (int idx = gtid; idx < NTOK * 128; idx += NT) {
        const int tok = idx >> 7, rem = idx & 127, gi = rem >> 5, c8 = rem & 31, ch = gi * 256 + c8 * 8, w = 2 << gi;
        float s[8];
#pragma unroll
        for (int e = 0; e < 8; ++e) s[e] = 0.f;
        float ut[8]; float cnt;
        if (tok < NPR) { const int t = tok & (SEQ - 1); const int lo = (t - w + 1) > 0 ? (t - w + 1) : 0; cnt = (float)(t - lo + 1);
            for (int tau = lo; tau <= t; ++tau) { const u32x4 p = *(const u32x4*)(proj + (size_t)(tok - t + tau) * PLD + PC_U + ch);
                ut[0] = bflo(p.x); ut[1] = bfhi(p.x); ut[2] = bflo(p.y); ut[3] = bfhi(p.y); ut[4] = bflo(p.z); ut[5] = bfhi(p.z); ut[6] = bflo(p.w); ut[7] = bfhi(p.w);
#pragma unroll
                for (int e = 0; e < 8; ++e) s[e] += ut[e]; }
        } else { const int bs = (tok - NPR) >> 3, t = tok & 7; cnt = (float)w;
            for (int tau = t - w + 1; tau <= t; ++tau) {
                if (tau >= 0) { const u32x4 p = *(const u32x4*)(proj + (size_t)(tok - t + tau) * PLD + PC_U + ch);
                    ut[0] = bflo(p.x); ut[1] = bfhi(p.x); ut[2] = bflo(p.y); ut[3] = bfhi(p.y); ut[4] = bflo(p.z); ut[5] = bfhi(p.z); ut[6] = bflo(p.w); ut[7] = bfhi(p.w);
                } else { const float* bp = spool + ((size_t)bs * 15 + 15 + tau) * 1024 + ch; const f32x4 x0 = *(const f32x4*)bp, x1 = *(const f32x4*)(bp + 4);
                    ut[0] = x0.x; ut[1] = x0.y; ut[2] = x0.z; ut[3] = x0.w; ut[4] = x1.x; ut[5] = x1.y; ut[6] = x1.z; ut[7] = x1.w; }
#pragma unroll
                for (int e = 0; e < 8; ++e) s[e] += ut[e]; }
        }
        const float ic = 1.0f / cnt; u32x4 o;
        o.x = cvtpk(s[0] * ic - ut[0], s[1] * ic - ut[1]); o.y = cvtpk(s[2] * ic - ut[2], s[3] * ic - ut[3]); o.z = cvtpk(s[4] * ic - ut[4], s[5] * ic - ut[5]); o.w = cvtpk(s[6] * ic - ut[6], s[7] * ic - ut[7]);
        *(u32x4*)(DP + ((size_t)gi * NTOK + tok) * 256 + c8 * 8) = o;
    }
    float* spp = a.out + O_SPP + (size_t)l * 4 * 15 * 1024; float* sps = a.out + O_SPS + (size_t)l * 128 * 15 * 1024;
    for (int idx = gtid; idx < (4 + 128) * 15 * 128; idx += NT) {
        const int c8 = idx & 127, rj = idx >> 7, ch = c8 * 8;
        if (rj < 60) { const int bq = rj / 15, j = rj - bq * 15;
            const u32x4 p = *(const u32x4*)(proj + (size_t)(bq * SEQ + SEQ - 15 + j) * PLD + PC_U + ch); float* o = spp + ((size_t)bq * 15 + j) * 1024 + ch;
            *(f32x4*)o = (f32x4){bflo(p.x), bfhi(p.x), bflo(p.y), bfhi(p.y)}; *(f32x4*)(o + 4) = (f32x4){bflo(p.z), bfhi(p.z), bflo(p.w), bfhi(p.w)};
        } else { const int r2 = rj - 60, bs = r2 / 15, j = r2 - bs * 15; float* o = sps + ((size_t)bs * 15 + j) * 1024 + ch;
            if (j < 7) { const float* bp = spool + ((size_t)bs * 15 + 8 + j) * 1024 + ch; *(f32x4*)o = *(const f32x4*)bp; *(f32x4*)(o + 4) = *(const f32x4*)(bp + 4); }
            else { const u32x4 p = *(const u32x4*)(proj + (size_t)(NPR + bs * 8 + j - 7) * PLD + PC_U + ch);
                *(f32x4*)o = (f32x4){bflo(p.x), bfhi(p.x), bflo(p.y), bfhi(p.y)}; *(f32x4*)(o + 4) = (f32x4){bflo(p.z), bfhi(p.z), bflo(p.w), bfhi(p.w)}; } }
    }
}

__device__ __forceinline__ void gla_scan_phase(const Args& a, int l, int NT, int bx, int wave) {
    const int gtid = bx * 512 + wave * 64 + lane_id();
    const float* UT = (const float*)(a.ws + WS_UT); const float* DEC = (const float*)(a.ws + WS_DEC); bf16_t* ST = (bf16_t*)(a.ws + WS_ST);
    float* sgp = a.out + O_SGP + (size_t)l * 16 * DK * DV;
    for (int g = gtid; g < 16 * DV * 32; g += NT) {
        const int bh = g >> 13, dv = (g >> 5) & 255, dk4 = (g & 31) * 4;
        f32x4 s = {0.f, 0.f, 0.f, 0.f};
#pragma unroll 8
        for (int c = 0; c < NCH; ++c) { const size_t o = ((size_t)(bh * NCH + c) * DV + dv) * DK + dk4;
            const f32x4 u = *(const f32x4*)(UT + o); const f32x4 dc = *(const f32x4*)(DEC + (size_t)(bh * NCH + c) * DK + dk4);
            u32x2 w; w.x = cvtpk(s.x, s.y); w.y = cvtpk(s.z, s.w); *(u32x2*)(ST + o) = w;
            s = dc * s + u; }
        float* op = sgp + ((size_t)bh * DK + dk4) * DV + dv; op[0] = s.x; op[DV] = s.y; op[2 * DV] = s.z; op[3 * DV] = s.w;
    }
}

__device__ __forceinline__ void gla_c_unit(const Args& a, int l, int unit, LAS unsigned char* lds, int wave) {
    const int lane = lane_id(), tid = wave * 64 + lane;
    const int bh = unit >> 5, c = unit & 31, b = bh >> 2, h = bh & 3, tok0 = b * SEQ + c * 64;
    const bf16_t* proj = (const bf16_t*)(a.ws + WS_PROJ); const bf16_t* QT = (const bf16_t*)(a.ws + WS_QT); const bf16_t* KT = (const bf16_t*)(a.ws + WS_KT);
    const bf16_t* ST = (const bf16_t*)(a.ws + WS_ST); bf16_t* A2 = (bf16_t*)(a.ws + WS_A2);
    LAS bf16_t* Lq = (LAS bf16_t*)(lds);
    LAS bf16_t* Lk = (LAS bf16_t*)(lds + 17408);
    LAS bf16_t* Lp = (LAS bf16_t*)(lds + 34816);
    LAS bf16_t* Lv = (LAS bf16_t*)(lds + 45056);
    LAS float* Lss = (LAS float*)(lds + 78336);
    const int lr = lane & 15, lq = lane >> 4, dv0 = wave * 32;
    bf16x8 sf[2][4];
#pragma unroll
    for (int nd = 0; nd < 2; ++nd)
#pragma unroll
        for (int ks = 0; ks < 4; ++ks) sf[nd][ks] = *(const bf16x8*)(ST + ((size_t)unit * DV + dv0 + nd * 16 + lr) * DK + ks * 32 + 8 * lq);
#pragma unroll
    for (int i = 0; i < 2; ++i) { const int p = tid + 512 * i, row = p >> 4, c16 = p & 15;
        *(LAS u32x4*)(Lq + row * 136 + c16 * 8) = *(const u32x4*)(QT + (size_t)(unit * 64 + row) * DK + c16 * 8);
        *(LAS u32x4*)(Lk + row * 136 + c16 * 8) = *(const u32x4*)(KT + (size_t)(unit * 64 + row) * DK + c16 * 8); }
#pragma unroll
    for (int i = 0; i < 4; ++i) { const int p = tid + 512 * i, t = p >> 5, c16 = p & 31;
        const u32x4 v = *(const u32x4*)(proj + (size_t)(tok0 + t) * PLD + PC_V + h * DV + c16 * 8);
        LAS u32x2* d = (LAS u32x2*)(Lv + t * 260 + c16 * 8); d[0] = (u32x2){v.x, v.y}; d[1] = (u32x2){v.z, v.w}; }
    __syncthreads();
    { const int mi = wave >> 1;
#pragma unroll
        for (int jj = 0; jj < 2; ++jj) { const int nj = (wave & 1) * 2 + jj; f32x4 acc = {0.f, 0.f, 0.f, 0.f};
            if (nj <= mi) {
#pragma unroll
                for (int ks = 0; ks < 4; ++ks) { const bf16x8 kf = *(const LAS bf16x8*)(Lk + (nj * 16 + lr) * 136 + ks * 32 + 8 * lq), qf = *(const LAS bf16x8*)(Lq + (mi * 16 + lr) * 136 + ks * 32 + 8 * lq);
                    acc = __builtin_amdgcn_mfma_f32_16x16x32_bf16(kf, qf, acc, 0, 0, 0); }
                const int i = mi * 16 + lr, j0 = nj * 16 + lq * 4;
#pragma unroll
                for (int r = 0; r < 4; ++r) if (j0 + r > i) acc[r] = 0.f;
            }
            u32x2 w; w.x = cvtpk(acc[0], acc[1]); w.y = cvtpk(acc[2], acc[3]); *(LAS u32x2*)(Lp + (mi * 16 + lr) * 72 + nj * 16 + lq * 4) = w; } }
    __syncthreads();
    f32x4 o[4][2];
#pragma unroll
    for (int mi = 0; mi < 4; ++mi)
#pragma unroll
        for (int nd = 0; nd < 2; ++nd) o[mi][nd] = (f32x4){0.f, 0.f, 0.f, 0.f};
#pragma unroll
    for (int ks = 0; ks < 2; ++ks) { bf16x8 vf[2];
#pragma unroll
        for (int nd = 0; nd < 2; ++nd)
#pragma unroll
            for (int j = 0; j < 8; ++j) vf[nd][j] = (short)Lv[(ks * 32 + 8 * lq + j) * 260 + dv0 + nd * 16 + lr];
#pragma unroll
        for (int mi = 0; mi < 4; ++mi) { const bf16x8 pf = *(const LAS bf16x8*)(Lp + (mi * 16 + lr) * 72 + ks * 32 + 8 * lq);
#pragma unroll
            for (int nd = 0; nd < 2; ++nd) o[mi][nd] = __builtin_amdgcn_mfma_f32_16x16x32_bf16(vf[nd], pf, o[mi][nd], 0, 0, 0); } }
#pragma unroll
    for (int ks = 0; ks < 4; ++ks)
#pragma unroll
        for (int mi = 0; mi < 4; ++mi) { const bf16x8 qf = *(const LAS bf16x8*)(Lq + (mi * 16 + lr) * 136 + ks * 32 + 8 * lq);
#pragma unroll
            for (int nd = 0; nd < 2; ++nd) o[mi][nd] = __builtin_amdgcn_mfma_f32_16x16x32_bf16(sf[nd][ks], qf, o[mi][nd], 0, 0, 0); }
#pragma unroll
    for (int mi = 0; mi < 4; ++mi) { float ss = 0.f;
#pragma unroll
        for (int nd = 0; nd < 2; ++nd) { const f32x4 x = o[mi][nd]; ss += (x.x * x.x + x.y * x.y) + (x.z * x.z + x.w * x.w); }
        ss = xor16_sum(ss); ss = xor32_sum(ss);
        if (lq == 0) Lss[(mi * 16 + lr) * 8 + wave] = ss; }
    __syncthreads();
#pragma unroll
    for (int mi = 0; mi < 4; ++mi) { const int t = mi * 16 + lr; const f32x4 s0 = *(const LAS f32x4*)(Lss + t * 8), s1 = *(const LAS f32x4*)(Lss + t * 8 + 4);
        const float r = rsqrtf((((s0.x + s0.y) + (s0.z + s0.w)) + ((s1.x + s1.y) + (s1.z + s1.w))) * (1.0f / DV) + EPS);
#pragma unroll
        for (int nd = 0; nd < 2; ++nd) { const int dvg = dv0 + nd * 16 + lq * 4;
            const u32x2 gp = *(const u32x2*)(proj + (size_t)(tok0 + t) * PLD + PC_G + h * DV + dvg);
            const f32x4 gn = *(const f32x4*)(a.in[I_GNORM] + l * DV + dvg); const f32x4 x = o[mi][nd];
            const float o0 = x.x * r * gn.x * silu_f(bflo(gp.x)), o1 = x.y * r * gn.y * silu_f(bfhi(gp.x)), o2 = x.z * r * gn.z * silu_f(bflo(gp.y)), o3 = x.w * r * gn.w * silu_f(bfhi(gp.y));
            u32x2 w; w.x = cvtpk(o0, o1); w.y = cvtpk(o2, o3); *(u32x2*)(A2 + (size_t)(tok0 + t) * DM + h * DV + dvg) = w; } }
    __syncthreads();
}

__device__ __forceinline__ void final_norm_phase(const Args& a, int gw, int NGW) {
    const int lane = lane_id();
    float* X = a.out + O_Y; const float* ssp = (const float*)(a.ws + WS_SSP); const float* gn = a.in[I_NFIN];
    for (int m = gw; m < NTOK; m += NGW) {
        float ss = (lane < 32) ? ssp[(size_t)m * 32 + lane] : 0.f; ss = wave_sum(ss);
        const float r = rsqrtf(ss * (1.0f / DM) + EPS);
#pragma unroll
        for (int j = 0; j < 8; ++j) { f32x4* p = (f32x4*)(X + (size_t)m * DM) + lane + 64 * j; const f32x4 g4 = ((const f32x4*)gn)[lane + 64 * j]; const f32x4 v = *p; *p = (v * r) * g4; }
    }
}

#ifndef PM
#define PM 0xFFFF
#endif
#define PH(b) if constexpr ((PM >> (b)) & 1)
__global__ void __launch_bounds__(512, 2) fwd_megakernel(Args args) {
    extern __shared__ __attribute__((aligned(16))) unsigned char lds_raw[];
    LAS unsigned char* lds = (LAS unsigned char*)lds_raw;
    volatile LAS unsigned* MISC = (volatile LAS unsigned*)(lds + MISC_OFF);
    const int tid = threadIdx.x, wave0 = __builtin_amdgcn_readfirstlane(tid >> 6);
    const int G = gridDim.x, bx = blockIdx.x;
    for (int u = tid; u < (LDS_BYTES - LDSCTL_OFF) / 4; u += 512) ((LAS unsigned*)(lds + LDSCTL_OFF))[u] = 0u;
    __syncthreads();
    XcdBarrier bar = xcd_barrier_post((unsigned*)(args.ws + WS_CTL) + CW_BAR, MISC + 8);
#define OPQ() int G_ = G, bx_ = bx, wave = wave0; unsigned char* ws = args.ws; asm volatile("" : "+s"(G_), "+s"(bx_), "+s"(ws), "+s"(wave))

    PH(0) p0_prologue(args, lds, bx * 8 + wave0, G * 8, wave0);
    xcd_barrier(bar);
#pragma unroll 1
    for (int l = 0; l < 2; ++l) {
        PH(1) {
            OPQ(); unsigned char* wl = ws + WS_W + (size_t)l * W_LAYER;
            pg8::Gemm g{(const bf16_t*)(ws + WS_XB), (const bf16_t*)(wl + WO_IN)}; pg8::StaticOrder S; S.init(NTOK, INW, G_, bx_);
            pg8::EpiInProj E{(bf16_t*)(ws + WS_PROJ), (float*)(ws + WS_GKLR), (const float*)(ws + WS_SSP)};
            pg8::gemm_phase<pg8::EpiInProj, pg8::StaticOrder, DM, DM, DM, 0>(lds, g, S, E, wave);
        }
        xcd_barrier(bar);
        {
            OPQ();
            PH(2) for (int u = bx_; u < 512; u += G_) gla_sample_unit(args, l, u, lds, wave);
            PH(3) for (int u = bx_; u < 512; u += G_) gla_a_unit(args, l, u, lds, wave);
            PH(4) pool_d_phase(args, l, G_ * 512, bx_, wave);
        }
        xcd_barrier(bar);
        {
            OPQ(); unsigned char* wl = ws + WS_W + (size_t)l * W_LAYER;
            PH(5) gla_scan_phase(args, l, G_ * 512, bx_, wave);
            __syncthreads();
            PH(6) {
            pg8::Gemm g{(const bf16_t*)(ws + WS_DP), (const bf16_t*)(wl + WO_PL)}; pg8::PoolOrder S{G_, bx_};
            pg8::EpiPool E{(bf16_t*)(ws + WS_A2), args.in[I_PSCALE] + l * 1024};
            pg8::gemm_phase<pg8::EpiPool, pg8::PoolOrder, 256, 256, 256, 131072>(lds, g, S, E, wave); }
        }
        xcd_barrier(bar);
        {
            OPQ();
            PH(7) for (int u = bx_; u < 512; u += G_) gla_c_unit(args, l, u, lds, wave);
        }
        xcd_barrier(bar);
        PH(8) {
            OPQ(); unsigned char* wl = ws + WS_W + (size_t)l * W_LAYER; float* X = args.out + O_Y;
            pg8::Gemm g{(const bf16_t*)(ws + WS_A2), (const bf16_t*)(wl + WO_OUT)}; pg8::StaticOrder S; S.init(NTOK, DM, G_, bx_);
            pg8::EpiResid E{l == 0 ? args.in[I_XP] : X, l == 0 ? args.in[I_XS] - (size_t)NPR * DM : X, X, (bf16_t*)(ws + WS_XB), (float*)(ws + WS_SSP)};
            pg8::gemm_phase<pg8::EpiResid, pg8::StaticOrder, DM, DM, DM, 0>(lds, g, S, E, wave);
        }
        xcd_barrier(bar);
        PH(9) {
            OPQ(); unsigned char* wl = ws + WS_W + (size_t)l * W_LAYER;
            pg8::Gemm g{(const bf16_t*)(ws + WS_XB), (const bf16_t*)(wl + WO_GU)}; pg8::StaticOrder S; S.init(NTOK, 2 * DFF, G_, bx_);
            pg8::EpiGateUp E{(bf16_t*)(ws + WS_ACT), (const float*)(ws + WS_SSP)};
            pg8::gemm_phase<pg8::EpiGateUp, pg8::StaticOrder, DM, DM, DM, 0>(lds, g, S, E, wave);
        }
        xcd_barrier(bar);
        PH(10) {
            OPQ(); unsigned char* wl = ws + WS_W + (size_t)l * W_LAYER; float* X = args.out + O_Y;
            pg8::Gemm g{(const bf16_t*)(ws + WS_ACT), (const bf16_t*)(wl + WO_DN)}; pg8::StaticOrder S; S.init(NTOK, DM, G_, bx_);
            pg8::EpiResid E{X, X, X, (bf16_t*)(ws + WS_XB), (float*)(ws + WS_SSP)};
            pg8::gemm_phase<pg8::EpiResid, pg8::StaticOrder, DFF, DFF, DFF, 0>(lds, g, S, E, wave);
        }
        xcd_barrier(bar);
    }
    PH(11) { OPQ(); final_norm_phase(args, bx_ * 8 + wave, G_ * 8); }
}

extern "C" void kernel_launch(void* const* d_in, const int* in_sizes, int n_in, void* d_out, int out_size, void* d_ws, size_t ws_size, hipStream_t stream) {
    static int grid = 0;
    if (grid == 0) {
        if (n_in != 17 || out_size != (int)O_END || ws_size < WS_END) { fprintf(stderr, "kernel_launch: unexpected shapes: n_in %d out %d ws %zu\n", n_in, out_size, ws_size); grid = -1; return; }
        int dev = 0, cus = 0;
        if (hipGetDevice(&dev) != hipSuccess || hipDeviceGetAttribute(&cus, hipDeviceAttributeMultiprocessorCount, dev) != hipSuccess) { grid = -1; return; }
        if (hipFuncSetAttribute((const void*)fwd_megakernel, hipFuncAttributeMaxDynamicSharedMemorySize, LDS_BYTES) != hipSuccess) { fprintf(stderr, "kernel_launch: hipFuncSetAttribute failed\n"); grid = -1; return; }
        int per_cu = 0;
        if (hipOccupancyMaxActiveBlocksPerMultiprocessor(&per_cu, (const void*)fwd_megakernel, 512, LDS_BYTES) != hipSuccess || per_cu < 1) fprintf(stderr, "kernel_launch: occupancy query reports %d\n", per_cu);
        (void)hipGetLastError();
        grid = cus;
    }
    if (grid < 0) return;
    if (hipMemsetAsync((char*)d_ws + WS_CTL, 0, CTL_ZERO_BYTES, stream) != hipSuccess) return;
    Args a{};
    for (int i = 0; i < 17; ++i) a.in[i] = (const float*)d_in[i];
    a.out = (float*)d_out; a.ws = (unsigned char*)d_ws;
    hipLaunchKernelGGL(fwd_megakernel, dim3(grid), dim3(512), LDS_BYTES, stream, a);
}
```

```cpp
#include <hip/hip_runtime.h>
#include <cstdio>
#include <cstdint>

#define LAS __attribute__((address_space(3)))
#define GAS __attribute__((address_space(1)))
typedef unsigned short bf16_t;
typedef short bf16x8 __attribute__((ext_vector_type(8)));
typedef float f32x4 __attribute__((ext_vector_type(4)));
typedef float f32x2 __attribute__((ext_vector_type(2)));
typedef unsigned u32x4 __attribute__((ext_vector_type(4)));
typedef unsigned u32x2 __attribute__((ext_vector_type(2)));
typedef __bf16 bf16x2_t __attribute__((ext_vector_type(2)));

constexpr int DM = 2048, NTOK = 9216, NPR = 8192, SEQ = 2048, DFF = 5632;
constexpr int INW = 4352, PLD = 4096;
constexpr int DK = 128, DV = 256, NCH = 32;
constexpr float EPS = 1e-6f;
constexpr int PC_Q = 0, PC_K = 512, PC_V = 1024, PC_G = 2048, PC_U = 3072;

constexpr size_t O_Y = 0, O_SGP = 18874368, O_SPP = 19922944, O_SGS = 20045824, O_SPS = 53600256, O_END = 57532416;

constexpr size_t MiB = 1u << 20;
constexpr size_t WS_CTL = 0, CTL_ZERO_BYTES = 1 * MiB;
constexpr size_t WS_SSP = 2 * MiB;
constexpr size_t WS_GKLR = 4 * MiB;
constexpr size_t WS_DEC = 5 * MiB;
constexpr size_t WS_W = 8 * MiB, W_LAYER = 92 * MiB;
constexpr size_t WO_IN = 0, WO_OUT = 17 * MiB, WO_GU = 25 * MiB, WO_DN = 69 * MiB, WO_PL = 91 * MiB;
constexpr size_t WS_XB = 192 * MiB;
constexpr size_t WS_A2 = 228 * MiB;
constexpr size_t WS_PROJ = 264 * MiB;
constexpr size_t WS_QT = 336 * MiB, WS_KT = 344 * MiB;
constexpr size_t WS_UT = 352 * MiB;
constexpr size_t WS_ST = 416 * MiB;
constexpr size_t WS_DP = 448 * MiB;
constexpr size_t WS_ACT = 264 * MiB;
constexpr size_t WS_END = 468 * MiB;
static_assert(WS_ACT + (size_t)NTOK * DFF * 2 <= WS_ST, "ACT overlay");
static_assert(WS_DP + (size_t)4 * NTOK * 256 * 2 <= WS_END, "DP");

constexpr int CW_BAR = 4096;

constexpr int RING_BYTES = 131072, LDSCTL_OFF = RING_BYTES, MISC_OFF = LDSCTL_OFF + 320, LDS_BYTES = 147456;

__device__ __forceinline__ unsigned cvtpk(float lo, float hi) { f32x2 v = {lo, hi}; bf16x2_t b = __builtin_convertvector(v, bf16x2_t); return __builtin_bit_cast(unsigned, b); }
__device__ __forceinline__ float bf2f(unsigned short b) { return __uint_as_float((unsigned)b << 16); }
__device__ __forceinline__ float bflo(unsigned w) { return __uint_as_float(w << 16); }
__device__ __forceinline__ float bfhi(unsigned w) { return __uint_as_float(w & 0xffff0000u); }
__device__ __forceinline__ float silu_f(float x) { return x * __builtin_amdgcn_rcpf(1.0f + __builtin_amdgcn_exp2f(-1.4426950408889634f * x)); }
__device__ __forceinline__ float logsig(float x) { return fminf(x, 0.f) - log1pf(expf(-fabsf(x))); }
__device__ __forceinline__ int lane_id() { int l = __builtin_amdgcn_mbcnt_hi(~0u, __builtin_amdgcn_mbcnt_lo(~0u, 0u)); asm volatile("" : "+v"(l)); return l; }
#define LDS_WAIT() asm volatile("s_waitcnt lgkmcnt(0)" ::: "memory")
#define VM_WAIT() asm volatile("s_waitcnt vmcnt(0)" ::: "memory")
template <int CTRL> __device__ __forceinline__ float dppf(float v) { return __int_as_float(__builtin_amdgcn_update_dpp(0, __float_as_int(v), CTRL, 0xf, 0xf, true)); }
__device__ __forceinline__ float xor16_sum(float s) { auto r = __builtin_amdgcn_permlane16_swap(__float_as_uint(s), __float_as_uint(s), false, false); return __uint_as_float(r[0]) + __uint_as_float(r[1]); }
__device__ __forceinline__ float xor32_sum(float s) { auto r = __builtin_amdgcn_permlane32_swap(__float_as_uint(s), __float_as_uint(s), false, false); return __uint_as_float(r[0]) + __uint_as_float(r[1]); }
__device__ __forceinline__ float wave_sum(float v) {
    v += dppf<0xB1>(v); v += dppf<0x4E>(v); v += dppf<0x141>(v); v += dppf<0x140>(v);
    v = xor16_sum(v); return xor32_sum(v);
}

namespace pg8 {
constexpr int BM = 256, BK = 64, HALF = 128, HTB = HALF * BK * 2, STAGE_BYTES = 8 * HTB, NXCD = 8, WGM = 8;
__host__ __device__ __forceinline__ int lds_byte(int r, int c) { const int st = (r >> 4) * 2 + (c >> 5), rr = r & 15, cc = c & 31, ob = rr * 64 + cc * 2; return st * 1024 + (ob ^ (((ob >> 9) & 1) << 5)); }
__host__ __device__ __forceinline__ void stage_rc(int b, int& R, int& C) { const int st = b / 1024, sb = b % 1024, swz = sb ^ (((sb >> 9) & 1) << 5); R = (st >> 1) * 16 + swz / 64; C = (st & 1) * 32 + (swz % 64) / 2; }
__host__ __device__ __forceinline__ int perm32(int rho) { const int n = rho >> 4, i = rho & 15; return 8 * (i >> 2) + 4 * n + (i & 3); }

struct Unit { int pm, pn, bsel; };
struct Gemm { const bf16_t* A; const bf16_t* Bt; };

struct StaticOrder {
    int nM, nN, nwg, G, c;
    __device__ void init(int M, int N, int G_, int c_) { nM = M / BM; nN = N / BM; nwg = nM * nN; G = G_; c = c_; }
    __device__ bool next(int i, Unit& u) const {
        const long L = (long)i * G + c; if (L >= nwg) return false;
        int wgid = (int)L; { const int q = nwg / NXCD, r = nwg % NXCD, xcd = wgid % NXCD, off = wgid / NXCD; wgid = (xcd < r ? xcd * (q + 1) : r * (q + 1) + (xcd - r) * q) + off; }
        const int nig = WGM * nN, gid = wgid / nig, fm = gid * WGM, gsz = (nM - fm) < WGM ? (nM - fm) : WGM;
        u.pm = fm + ((wgid % nig) % gsz); u.pn = (wgid % nig) / gsz; u.bsel = 0; return true;
    }
};
struct PoolOrder {
    int G, c;
    __device__ bool next(int i, Unit& u) const { const int L = i * G + c; if (L >= 144) return false; u.pm = L; u.pn = 0; u.bsel = L / 36; return true; }
};

template <class Epi, class Sched, int LDA, int LDB, int K, int BSEL>
__device__ __forceinline__ void gemm_phase(LAS unsigned char* lds, const Gemm g, const Sched& S, const Epi& E, int wid) {
    const int lane = lane_id(), tid = wid * 64 + lane, wr = wid >> 2, wc = wid & 3, fr = lane & 15, fq = lane >> 4;
    constexpr int nt = K / BK;
    unsigned voffA[2], voffB[2];
#pragma unroll
    for (int i = 0; i < 2; ++i) { int R, C; stage_rc(tid * 16 + i * 8192, R, C); const int Rb = Epi::PERM ? ((R & ~31) + perm32(R & 31)) : R;
        voffA[i] = (unsigned)(R * LDA + C) * 2u; voffB[i] = (unsigned)(Rb * LDB + C) * 2u; }
    constexpr size_t kstep = (size_t)(BK * 2);
    constexpr size_t hstA = (size_t)HALF * LDA * 2, hstB = (size_t)HALF * LDB * 2;
    constexpr size_t tstA = 2 * hstA, tstB = 2 * hstB;
    const unsigned ldsw = (unsigned)wid * 1024u;
    const int aoff = lds_byte(wr * 64 + fr, fq * 8), boff = lds_byte(wc * 32 + fr, fq * 8);
#define PG8_SA(b, h) (((b) * 2 + (h)) * HTB)
#define PG8_SB(b, h) ((4 + (b) * 2 + (h)) * HTB)
#define PG8_STAGE(bufoff, gbase, voff) do { _Pragma("unroll") for (int _i = 0; _i < 2; ++_i) \
        __builtin_amdgcn_global_load_lds((const unsigned*)((const char*)(gbase) + (voff)[_i]), (LAS unsigned*)(lds + (bufoff) + ldsw + _i * 8192), 16, 0, 0); } while (0)
#define PG8_LDA(dst, b, h) do { _Pragma("unroll") for (int m = 0; m < 4; ++m) _Pragma("unroll") for (int k = 0; k < 2; ++k) dst[m][k] = *(const LAS bf16x8*)(lds + PG8_SA(b, h) + aoff + m * 2048 + k * 1024); } while (0)
#define PG8_LDB(dst, b, h) do { _Pragma("unroll") for (int n = 0; n < 2; ++n) _Pragma("unroll") for (int k = 0; k < 2; ++k) dst[n][k] = *(const LAS bf16x8*)(lds + PG8_SB(b, h) + boff + n * 2048 + k * 1024); } while (0)
#define PG8_MMA(ai, bj, At, Bt) do { __builtin_amdgcn_s_setprio(1); _Pragma("unroll") for (int m = 0; m < 4; ++m) _Pragma("unroll") for (int n = 0; n < 2; ++n) _Pragma("unroll") for (int k = 0; k < 2; ++k) \
        acc[ai][bj][m][n] = __builtin_amdgcn_mfma_f32_16x16x32_bf16(Bt[n][k], At[m][k], acc[ai][bj][m][n], 0, 0, 0); __builtin_amdgcn_s_setprio(0); } while (0)
#define PG8_WAIT_V(n) asm volatile("s_waitcnt vmcnt(" #n ")" ::: "memory")
#define PG8_WAIT_L(n) asm volatile("s_waitcnt lgkmcnt(" #n ")" ::: "memory")
#define PG8_BAR __builtin_amdgcn_s_barrier()
#define PG8_SCHED __builtin_amdgcn_sched_barrier(0)
    Unit cur, nxt; int ui = 0;
    if (!S.next(0, cur)) return;
    f32x4 acc[2][2][4][2];
#pragma unroll
    for (int a = 0; a < 2; ++a)
#pragma unroll
        for (int b = 0; b < 2; ++b)
#pragma unroll
            for (int m = 0; m < 4; ++m)
#pragma unroll
                for (int n = 0; n < 2; ++n) acc[a][b][m][n] = (f32x4){0.f, 0.f, 0.f, 0.f};
    bf16x8 At[4][2], B0[2][2], B1[2][2];
    const char* cA = (const char*)g.A + (size_t)cur.pm * tstA; const char* cB = (const char*)g.Bt + (size_t)cur.pn * tstB + (size_t)cur.bsel * BSEL;
    PG8_STAGE(PG8_SB(0, 0), cB, voffB); PG8_STAGE(PG8_SB(0, 1), cB + hstB, voffB); PG8_STAGE(PG8_SA(0, 0), cA, voffA); PG8_STAGE(PG8_SA(0, 1), cA + hstA, voffA);
    if (wr == 1) PG8_BAR;
    PG8_WAIT_V(2); PG8_BAR;
    PG8_STAGE(PG8_SB(1, 0), cB + kstep, voffB); PG8_STAGE(PG8_SA(1, 0), cA + kstep, voffA); PG8_STAGE(PG8_SB(1, 1), cB + hstB + kstep, voffB);
    PG8_WAIT_V(6); PG8_BAR;
    for (;;) {
        const bool has_next = S.next(ui + 1, nxt);
        const char* nA = has_next ? (const char*)g.A + (size_t)nxt.pm * tstA : cA;
        const char* nB = has_next ? (const char*)g.Bt + (size_t)nxt.pn * tstB + (size_t)nxt.bsel * BSEL : cB;
#pragma unroll 1
        for (int t = 0; t < nt; t += 2) {
            const bool last = (t == nt - 2);
            const char* a1 = cA + (size_t)(t + 1) * kstep;
            const char* a2 = last ? nA : cA + (size_t)(t + 2) * kstep; const char* b2 = last ? nB : cB + (size_t)(t + 2) * kstep;
            const char* a3 = a2 + kstep; const char* b3 = b2 + kstep;
            PG8_LDB(B0, 0, 0); PG8_LDB(B1, 0, 1); PG8_SCHED; PG8_LDA(At, 0, 0); PG8_STAGE(PG8_SA(1, 1), a1 + hstA, voffA);
            PG8_WAIT_V(8); PG8_WAIT_L(0); PG8_BAR; PG8_MMA(0, 0, At, B0); PG8_MMA(0, 1, At, B1); PG8_BAR; PG8_SCHED;
            PG8_LDA(At, 0, 1); PG8_STAGE(PG8_SB(0, 0), b2, voffB); PG8_STAGE(PG8_SB(0, 1), b2 + hstB, voffB); PG8_STAGE(PG8_SA(0, 0), a2, voffA);
            PG8_WAIT_V(8); PG8_WAIT_L(0); PG8_BAR; PG8_MMA(1, 0, At, B0); PG8_MMA(1, 1, At, B1); PG8_BAR; PG8_SCHED;
            PG8_LDB(B0, 1, 0); PG8_LDB(B1, 1, 1); PG8_SCHED; PG8_LDA(At, 1, 0); PG8_STAGE(PG8_SA(0, 1), a2 + hstA, voffA);
            PG8_WAIT_V(8); PG8_WAIT_L(0); PG8_BAR; PG8_MMA(0, 0, At, B0); PG8_MMA(0, 1, At, B1); PG8_BAR; PG8_SCHED;
            PG8_LDA(At, 1, 1); PG8_STAGE(PG8_SB(1, 0), b3, voffB); PG8_STAGE(PG8_SB(1, 1), b3 + hstB, voffB); PG8_STAGE(PG8_SA(1, 0), a3, voffA);
            PG8_WAIT_V(8); PG8_WAIT_L(0); PG8_BAR; PG8_MMA(1, 0, At, B0); PG8_MMA(1, 1, At, B1); PG8_BAR; PG8_SCHED;
        }
        if (wr == 0) PG8_BAR;
        E(acc, cur, wr, wc, fr, fq);
        if (!has_next) break;
#pragma unroll
        for (int a = 0; a < 2; ++a)
#pragma unroll
            for (int b = 0; b < 2; ++b)
#pragma unroll
                for (int m = 0; m < 4; ++m)
#pragma unroll
                    for (int n = 0; n < 2; ++n) acc[a][b][m][n] = (f32x4){0.f, 0.f, 0.f, 0.f};
        cur = nxt; cA = nA; cB = nB; ++ui;
        if (wr == 1) PG8_BAR;
    }
    PG8_WAIT_V(0);
    PG8_BAR;
#undef PG8_SA
#undef PG8_SB
#undef PG8_STAGE
#undef PG8_LDA
#undef PG8_LDB
#undef PG8_MMA
#undef PG8_WAIT_V
#undef PG8_WAIT_L
#undef PG8_BAR
#undef PG8_SCHED
}

__device__ __forceinline__ void load_rscale(const float* ssp, int row0, int fq, float (&rs)[2][4]) {
#pragma unroll
    for (int ai = 0; ai < 2; ++ai)
#pragma unroll
        for (int m = 0; m < 4; ++m) {
            const f32x4* p = (const f32x4*)(ssp + (size_t)(row0 + ai * HALF + m * 16) * 32 + fq * 8);
            const f32x4 a = p[0], b = p[1];
            float s = ((a.x + a.y) + (a.z + a.w)) + ((b.x + b.y) + (b.z + b.w));
            s = xor16_sum(s); s = xor32_sum(s);
            rs[ai][m] = rsqrtf(s * (1.0f / DM) + EPS);
        }
}
struct EpiInProj {
    static constexpr bool PERM = true;
    bf16_t* proj; float* gklr; const float* ssp;
    __device__ __forceinline__ void operator()(const f32x4 (&acc)[2][2][4][2], const Unit& u, int wr, int wc, int fr, int fq) const {
        const int row0 = u.pm * BM + wr * 64 + fr;
        float rs[2][4]; load_rscale(ssp, row0, fq, rs);
        if (u.pn < 16) {
            const int col0 = u.pn * BM + wc * 32 + 8 * fq;
#pragma unroll
            for (int ai = 0; ai < 2; ++ai)
#pragma unroll
                for (int m = 0; m < 4; ++m) { bf16_t* rowp = proj + (size_t)(row0 + ai * HALF + m * 16) * PLD + col0; const float s = rs[ai][m];
#pragma unroll
                    for (int bj = 0; bj < 2; ++bj) { const f32x4 v0 = acc[ai][bj][m][0] * s, v1 = acc[ai][bj][m][1] * s;
                        u32x4 w; w.x = cvtpk(v0[0], v0[1]); w.y = cvtpk(v0[2], v0[3]); w.z = cvtpk(v1[0], v1[1]); w.w = cvtpk(v1[2], v1[3]);
                        *(u32x4*)(rowp + bj * HALF) = w; } }
        } else if (wc == 0 && fq < 2) {
#pragma unroll
            for (int ai = 0; ai < 2; ++ai)
#pragma unroll
                for (int m = 0; m < 4; ++m) { float* gp = gklr + (size_t)(row0 + ai * HALF + m * 16) * 16 + 8 * fq; const float s = rs[ai][m];
                    *(f32x4*)(gp) = acc[ai][0][m][0] * s; *(f32x4*)(gp + 4) = acc[ai][0][m][1] * s; }
        }
    }
};
struct EpiResid {
    static constexpr bool PERM = false;
    const float* base_p; const float* base_s; float* X; bf16_t* xb; float* ssp;
    __device__ __forceinline__ void operator()(const f32x4 (&acc)[2][2][4][2], const Unit& u, int wr, int wc, int fr, int fq) const {
        const int row0 = u.pm * BM + wr * 64 + fr, col0 = u.pn * BM + wc * 32 + 4 * fq;
        const float* base = (u.pm < NPR / BM) ? base_p : base_s;
#pragma unroll
        for (int ai = 0; ai < 2; ++ai)
#pragma unroll
            for (int m = 0; m < 4; ++m) { const int row = row0 + ai * HALF + m * 16; const size_t off = (size_t)row * DM + col0; float ss = 0.f;
#pragma unroll
                for (int bj = 0; bj < 2; ++bj)
#pragma unroll
                    for (int n = 0; n < 2; ++n) { const f32x4 bs = *(const f32x4*)(base + off + bj * HALF + n * 16); const f32x4 o = bs + acc[ai][bj][m][n];
                        *(f32x4*)(X + off + bj * HALF + n * 16) = o; ss += (o[0] * o[0] + o[1] * o[1]) + (o[2] * o[2] + o[3] * o[3]);
                        u32x2 w; w.x = cvtpk(o[0], o[1]); w.y = cvtpk(o[2], o[3]); *(u32x2*)(xb + off + bj * HALF + n * 16) = w; }
                ss = xor16_sum(ss); ss = xor32_sum(ss);
                if (fq == 0) ssp[(size_t)row * 32 + u.pn * 4 + wc] = ss;
                asm volatile("" ::: "memory"); }
    }
};
struct EpiGateUp {
    static constexpr bool PERM = true;
    bf16_t* act; const float* ssp;
    __device__ __forceinline__ void operator()(const f32x4 (&acc)[2][2][4][2], const Unit& u, int wr, int wc, int fr, int fq) const {
        const int row0 = u.pm * BM + wr * 64 + fr, col0 = u.pn * HALF + wc * 32 + 8 * fq;
        float rs[2][4]; load_rscale(ssp, row0, fq, rs);
#pragma unroll
        for (int ai = 0; ai < 2; ++ai)
#pragma unroll
            for (int m = 0; m < 4; ++m) { const float s = rs[ai][m]; float a[8];
#pragma unroll
                for (int n = 0; n < 2; ++n)
#pragma unroll
                    for (int e = 0; e < 4; ++e) { const float gt = acc[ai][0][m][n][e] * s, up = acc[ai][1][m][n][e] * s; a[n * 4 + e] = silu_f(gt) * up; }
                u32x4 w; w.x = cvtpk(a[0], a[1]); w.y = cvtpk(a[2], a[3]); w.z = cvtpk(a[4], a[5]); w.w = cvtpk(a[6], a[7]);
                *(u32x4*)(act + (size_t)(row0 + ai * HALF + m * 16) * DFF + col0) = w; }
    }
};
struct EpiPool {
    static constexpr bool PERM = true;
    bf16_t* a2; const float* pscale;
    __device__ __forceinline__ void operator()(const f32x4 (&acc)[2][2][4][2], const Unit& u, int wr, int wc, int fr, int fq) const {
        const int gi = u.pm / 36, tile = u.pm - gi * 36;
        const int row0 = tile * BM + wr * 64 + fr, col0 = gi * 256 + wc * 32 + 8 * fq;
        f32x4 sc[2][2];
#pragma unroll
        for (int bj = 0; bj < 2; ++bj)
#pragma unroll
            for (int n = 0; n < 2; ++n) sc[bj][n] = *(const f32x4*)(pscale + col0 + bj * HALF + 4 * n);
#pragma unroll
        for (int ai = 0; ai < 2; ++ai)
#pragma unroll
            for (int m = 0; m < 4; ++m) { bf16_t* rowp = a2 + (size_t)(row0 + ai * HALF + m * 16) * DM + 1024 + col0;
#pragma unroll
                for (int bj = 0; bj < 2; ++bj) { const f32x4 v0 = acc[ai][bj][m][0] * sc[bj][0], v1 = acc[ai][bj][m][1] * sc[bj][1];
                    u32x4 w; w.x = cvtpk(v0[0], v0[1]); w.y = cvtpk(v0[2], v0[3]); w.z = cvtpk(v1[0], v1[1]); w.w = cvtpk(v1[2], v1[3]);
                    *(u32x4*)(rowp + bj * HALF) = w; } }
    }
};
}

typedef GAS unsigned gu32;
#define RLX_AGENT __ATOMIC_RELAXED, __HIP_MEMORY_SCOPE_AGENT
#define XB_TMO      128
#define XB_XCNT(j)  (256  + 64 * (j))
#define XB_XSUB(j)  (1280 + 64 * (j))
#define XB_XGEN(j)  (2304 + 64 * (j))
#define XB_TOP      3328
#define XB_TOPGEN   3392
#define XCD_BAR_WORDS 3456
#define XB_SPIN_CAP (1u << 18)
__device__ __forceinline__ unsigned xb_ld(unsigned* p)              { return __hip_atomic_load(p, __ATOMIC_RELAXED, __HIP_MEMORY_SCOPE_AGENT); }
__device__ __forceinline__ unsigned xb_add(unsigned* p, unsigned v) { return __hip_atomic_fetch_add(p, v, __ATOMIC_RELAXED, __HIP_MEMORY_SCOPE_AGENT); }
__device__ __forceinline__ unsigned xb_xcc_id() { return (unsigned)__builtin_amdgcn_s_getreg((3 << 11) | 20) & 0xFu; }
#define XB_SPIN(cond, bar) do { unsigned _sp = 0; while (cond) { __builtin_amdgcn_s_sleep(1); \
    if ((++_sp & 255u) == 0u) { if (xb_ld(&(bar)[XB_TMO])) break; if (_sp > XB_SPIN_CAP) { atomicAdd(&(bar)[XB_TMO], 1u); break; } } } } while (0)
struct XcdBarrier { unsigned* bar; unsigned x; volatile LAS unsigned* st; };
__device__ __forceinline__ XcdBarrier xcd_barrier_post(unsigned* bar, volatile LAS unsigned* st) {
    XcdBarrier b; b.bar = bar; b.x = xb_xcc_id(); b.st = st;
    if (threadIdx.x == 0) (void)xb_add(&bar[XB_XCNT(b.x)], 1u);
    return b;
}
__device__ __forceinline__ void xcd_barrier_complete(unsigned* bar, unsigned x, unsigned& nloc, unsigned& nx) {
    const unsigned G = gridDim.x * gridDim.y * gridDim.z;
    unsigned sum, cnt, mine, sp = 0u;
    for (;;) {
        sum = 0u; cnt = 0u; mine = 0u;
#pragma unroll
        for (unsigned j = 0; j < 16; ++j) { const unsigned c = xb_ld(&bar[XB_XCNT(j)]); sum += c; cnt += (c > 0u) ? 1u : 0u; mine = (j == x) ? c : mine; }
        if (sum == G) break;
        __builtin_amdgcn_s_sleep(1);
        if ((++sp & 255u) == 0u) { if (xb_ld(&bar[XB_TMO])) break; if (sp > XB_SPIN_CAP) { atomicAdd(&bar[XB_TMO], 1u); break; } }
    }
    nloc = mine > 0u ? mine : 1u; nx = cnt > 0u ? cnt : 1u;
}
__device__ __forceinline__ void xcd_barrier(const XcdBarrier& b) {
    asm volatile("s_waitcnt vmcnt(0)" ::: "memory");
    __syncthreads();
    if (threadIdx.x == 0) {
        unsigned* bar = b.bar; unsigned bxid = b.x; asm volatile("" : "+s"(bar), "+s"(bxid));
        __builtin_amdgcn_s_waitcnt(0);
        unsigned nloc = b.st[0], nx = b.st[1];
        if (nloc == 0u) { xcd_barrier_complete(bar, bxid, nloc, nx); b.st[0] = nloc; b.st[1] = nx; }
        const unsigned old = xb_add(&bar[XB_XSUB(bxid)], 1u);
        const unsigned gen = old / nloc;
        if (old + 1u == (gen + 1u) * nloc) {
            __builtin_amdgcn_fence(__ATOMIC_RELEASE, "agent");
            asm volatile("s_waitcnt vmcnt(0)" ::: "memory");
            const unsigned og = xb_add(&bar[XB_TOP], 1u);
            const unsigned tg = og / nx;
            if (og + 1u == (tg + 1u) * nx) xb_add(&bar[XB_TOPGEN], 1u);
            else XB_SPIN(xb_ld(&bar[XB_TOPGEN]) == tg, bar);
            __builtin_amdgcn_fence(__ATOMIC_ACQUIRE, "agent");
            xb_add(&bar[XB_XGEN(bxid)], 1u);
            asm volatile("s_waitcnt vmcnt(0)" ::: "memory");
        } else {
            XB_SPIN(xb_ld(&bar[XB_XGEN(bxid)]) == gen, bar);
            __builtin_amdgcn_fence(__ATOMIC_ACQUIRE, "agent");
            asm volatile("s_waitcnt vmcnt(0)" ::: "memory");
        }
    }
    __syncthreads();
}

struct Args { const float* in[17]; float* out; unsigned char* ws; };
enum { I_XP = 0, I_XS, I_SG, I_SP, I_NMIX, I_WIN, I_WGK, I_BGK, I_GNORM, I_WPOOL, I_PSCALE, I_WOUT, I_NFFN, I_WGATE, I_WUP, I_WDOWN, I_NFIN };

__device__ __forceinline__ void transpose_item(const float* src, int ld, int nvalid, const float* kscale, float cscale, bf16_t* dst, int K, int k0, LAS float* scr, int lane) {
    const int c = lane & 31, cc = c < nvalid ? c : 0; const float msk = c < nvalid ? 1.f : 0.f;
    float v[32];
    if (nvalid > 0) {
        const float* sp = src + (size_t)(k0 + (lane >> 5)) * ld + cc;
#pragma unroll
        for (int i = 0; i < 32; ++i) v[i] = sp[(size_t)(2 * i) * ld];
    } else {
#pragma unroll
        for (int i = 0; i < 32; ++i) v[i] = 0.f;
    }
    const int ch = lane & 7;
    f32x4 ks0 = {cscale, cscale, cscale, cscale}, ks1 = ks0;
    if (kscale) { ks0 = *(const f32x4*)(kscale + k0 + 8 * ch) * cscale; ks1 = *(const f32x4*)(kscale + k0 + 8 * ch + 4) * cscale; }
#pragma unroll
    for (int i = 0; i < 32; ++i) scr[(2 * i + (lane >> 5)) * 33 + c] = v[i] * msk;
    LDS_WAIT(); asm volatile("" ::: "memory");
#pragma unroll
    for (int j = 0; j < 4; ++j) { const int n = (lane >> 3) + 8 * j; const LAS float* s = scr + (8 * ch) * 33 + n;
        u32x4 o; o.x = cvtpk(s[0 * 33] * ks0.x, s[1 * 33] * ks0.y); o.y = cvtpk(s[2 * 33] * ks0.z, s[3 * 33] * ks0.w); o.z = cvtpk(s[4 * 33] * ks1.x, s[5 * 33] * ks1.y); o.w = cvtpk(s[6 * 33] * ks1.z, s[7 * 33] * ks1.w);
        *(u32x4*)(dst + (size_t)n * K + k0 + 8 * ch) = o; }
    LDS_WAIT(); asm volatile("" ::: "memory");
}
constexpr int IT_IN = 32 * 136, IT_OUT = 32 * 64, IT_GU = 32 * 352, IT_DN = 88 * 64, IT_PL = 4 * 4 * 8, IT_LAYER = IT_IN + IT_OUT + IT_GU + IT_DN + IT_PL;
__device__ __forceinline__ void p0_prologue(const Args& a, LAS unsigned char* lds, int gw, int NGW, int wave) {
    const int lane = lane_id();
    LAS float* scr = (LAS float*)(lds + wave * 16384);
    for (int it = gw; it < 2 * IT_LAYER; it += NGW) {
        const int l = it / IT_LAYER; int r = it - l * IT_LAYER;
        unsigned char* wl = a.ws + WS_W + (size_t)l * W_LAYER;
        if (r < IT_IN) { const int kb = r / 136, nb = r - kb * 136, n0 = nb * 32;
            int sc, nv; if (n0 < 3072) { sc = n0; nv = 32; } else if (n0 < 4096) { sc = n0 + 16; nv = 32; } else if (n0 == 4096) { sc = 3072; nv = 16; } else { sc = 0; nv = 0; }
            transpose_item(a.in[I_WIN] + (size_t)l * DM * 4112 + sc, 4112, nv, a.in[I_NMIX] + l * DM, n0 < 512 ? 0.08838834764831845f : 1.f,
                           (bf16_t*)(wl + WO_IN) + (size_t)n0 * DM, DM, kb * 64, scr, lane); continue; } r -= IT_IN;
        if (r < IT_OUT) { const int kb = r / 64, nb = r - kb * 64, n0 = nb * 32;
            transpose_item(a.in[I_WOUT] + (size_t)l * DM * DM + n0, DM, 32, nullptr, 1.f, (bf16_t*)(wl + WO_OUT) + (size_t)n0 * DM, DM, kb * 64, scr, lane); continue; } r -= IT_OUT;
        if (r < IT_GU) { const int kb = r / 352, nb = r - kb * 352, n0 = nb * 32, t = n0 >> 8, rr = n0 & 255;
            const float* src = (rr < 128 ? a.in[I_WGATE] : a.in[I_WUP]) + (size_t)l * DM * DFF + 128 * t + (rr & 127);
            transpose_item(src, DFF, 32, a.in[I_NFFN] + l * DM, 1.f, (bf16_t*)(wl + WO_GU) + (size_t)n0 * DM, DM, kb * 64, scr, lane); continue; } r -= IT_GU;
        if (r < IT_DN) { const int kb = r / 64, nb = r - kb * 64, n0 = nb * 32;
            transpose_item(a.in[I_WDOWN] + (size_t)l * DFF * DM + n0, DM, 32, nullptr, 1.f, (bf16_t*)(wl + WO_DN) + (size_t)n0 * DFF, DFF, kb * 64, scr, lane); continue; } r -= IT_DN;
        { const int gi = r >> 5, q = r & 31, kb = q >> 3, nb = q & 7, n0 = nb * 32;
            transpose_item(a.in[I_WPOOL] + ((size_t)l * 4 + gi) * 65536 + n0, 256, 32, nullptr, 1.f, (bf16_t*)(wl + WO_PL) + (size_t)gi * 65536 + (size_t)n0 * 256, 256, kb * 64, scr, lane); }
    }
    bf16_t* xb = (bf16_t*)(a.ws + WS_XB); float* ssp = (float*)(a.ws + WS_SSP);
    for (int m = gw; m < NTOK; m += NGW) {
        const float* xr = (m < NPR) ? a.in[I_XP] + (size_t)m * DM : a.in[I_XS] + (size_t)(m - NPR) * DM;
        float ss = 0.f;
#pragma unroll
        for (int j = 0; j < 8; ++j) { const f32x4 v = ((const f32x4*)xr)[lane + 64 * j]; ss += (v.x * v.x + v.y * v.y) + (v.z * v.z + v.w * v.w);
            u32x2 w; w.x = cvtpk(v.x, v.y); w.y = cvtpk(v.z, v.w); ((u32x2*)(xb + (size_t)m * DM))[lane + 64 * j] = w; }
        ss = wave_sum(ss);
        if (lane < 32) ssp[(size_t)m * 32 + lane] = (lane == 0) ? ss : 0.f;
    }
}

__device__ __forceinline__ void gla_a_unit(const Args& a, int l, int unit, LAS unsigned char* lds, int wave) {
    const int lane = lane_id(), tid = wave * 64 + lane;
    const int bh = unit >> 5, c = unit & 31, b = bh >> 2, h = bh & 3, tok0 = b * SEQ + c * 64;
    const bf16_t* proj = (const bf16_t*)(a.ws + WS_PROJ); const float* gklr = (const float*)(a.ws + WS_GKLR);
    bf16_t* QT = (bf16_t*)(a.ws + WS_QT); bf16_t* KT = (bf16_t*)(a.ws + WS_KT); float* DEC = (float*)(a.ws + WS_DEC); bf16_t* UT = (bf16_t*)(a.ws + WS_UT);
    LAS float* Lgk = (LAS float*)(lds);
    LAS float* Lseg = (LAS float*)(lds + 4096);
    LAS bf16_t* Lkd = (LAS bf16_t*)(lds + 8192);
    LAS bf16_t* Lv = (LAS bf16_t*)(lds + 32768);
    if (tid < 256) ((LAS f32x4*)Lgk)[tid] = ((const f32x4*)(gklr + (size_t)tok0 * 16))[tid];
#pragma unroll
    for (int i = 0; i < 4; ++i) { const int p = tid + 512 * i, t = p >> 5, c16 = p & 31;
        const u32x4 v = *(const u32x4*)(proj + (size_t)(tok0 + t) * PLD + PC_V + h * DV + c16 * 8);
        LAS u32x2* d = (LAS u32x2*)(Lv + t * 260 + c16 * 8); d[0] = (u32x2){v.x, v.y}; d[1] = (u32x2){v.z, v.w}; }
    const int d = tid & 127, tq = tid >> 7;
    float w[16];
#pragma unroll
    for (int r = 0; r < 16; ++r) w[r] = a.in[I_WGK][(size_t)l * 16 * 512 + r * 512 + h * DK + d];
    const float bias = a.in[I_BGK][l * 512 + h * DK + d];
    unsigned short qv[16], kv[16];
#pragma unroll
    for (int i = 0; i < 16; ++i) { const size_t ro = (size_t)(tok0 + tq * 16 + i) * PLD + h * DK + d; qv[i] = proj[ro + PC_Q]; kv[i] = proj[ro + PC_K]; }
    __syncthreads();
    float bb[16]; float run = 0.f;
#pragma unroll
    for (int i = 0; i < 16; ++i) { const LAS f32x4* gp = (const LAS f32x4*)(Lgk + (tq * 16 + i) * 16); float x = bias;
#pragma unroll
        for (int r4 = 0; r4 < 4; ++r4) { const f32x4 g4 = gp[r4]; x += g4.x * w[4 * r4] + g4.y * w[4 * r4 + 1] + g4.z * w[4 * r4 + 2] + g4.w * w[4 * r4 + 3]; }
        run += logsig(x) * 0.0625f; bb[i] = run; }
    Lseg[tq * 128 + d] = run;
    __syncthreads();
    float off = 0.f, tot = 0.f;
#pragma unroll
    for (int q = 0; q < 4; ++q) { const float s = Lseg[q * 128 + d]; tot += s; if (q < tq) off += s; }
    unsigned kdp[8];
#pragma unroll
    for (int i = 0; i < 16; i += 2) { float kd2[2];
#pragma unroll
        for (int e = 0; e < 2; ++e) { const float bc = bb[i + e] + off, q = bf2f(qv[i + e]), k = bf2f(kv[i + e]);
            const size_t o = (size_t)(unit * 64 + tq * 16 + i + e) * DK + d;
            QT[o] = (bf16_t)(cvtpk(q * __expf(bc), 0.f) & 0xffffu); KT[o] = (bf16_t)(cvtpk(k * __expf(-bc), 0.f) & 0xffffu); kd2[e] = k * __expf(tot - bc); }
        kdp[i >> 1] = cvtpk(kd2[0], kd2[1]); }
    { LAS u32x4* kp = (LAS u32x4*)(Lkd + d * 72 + tq * 16); kp[0] = (u32x4){kdp[0], kdp[1], kdp[2], kdp[3]}; kp[1] = (u32x4){kdp[4], kdp[5], kdp[6], kdp[7]}; }
    if (tq == 0) DEC[(size_t)unit * DK + d] = __expf(tot);
    __syncthreads();
    const int dv0 = wave * 32, lr = lane & 15, lq = lane >> 4;
    bf16x8 vf[2][2];
#pragma unroll
    for (int mt = 0; mt < 2; ++mt)
#pragma unroll
        for (int ks = 0; ks < 2; ++ks)
#pragma unroll
            for (int j = 0; j < 8; ++j) vf[mt][ks][j] = (short)Lv[(ks * 32 + 8 * lq + j) * 260 + dv0 + mt * 16 + lr];
#pragma unroll
    for (int nt = 0; nt < 8; ++nt) {
        bf16x8 kf[2];
#pragma unroll
        for (int ks = 0; ks < 2; ++ks) kf[ks] = *(const LAS bf16x8*)(Lkd + (nt * 16 + lr) * 72 + ks * 32 + 8 * lq);
#pragma unroll
        for (int mt = 0; mt < 2; ++mt) { f32x4 acc = {0.f, 0.f, 0.f, 0.f};
#pragma unroll
            for (int ks = 0; ks < 2; ++ks) acc = __builtin_amdgcn_mfma_f32_16x16x32_bf16(kf[ks], vf[mt][ks], acc, 0, 0, 0);
            u32x2 w2; w2.x = cvtpk(acc[0], acc[1]); w2.y = cvtpk(acc[2], acc[3]); *(u32x2*)(UT + ((size_t)unit * DV + dv0 + mt * 16 + lr) * DK + nt * 16 + lq * 4) = w2; }
    }
    __syncthreads();
}

__device__ __forceinline__ void gla_sample_unit(const Args& a, int l, int unit, LAS unsigned char* lds, int wave) {
    const int lane = lane_id(), tid = wave * 64 + lane;
    const int b = unit >> 2, h = unit & 3, row0 = NPR + b * 8;
    const bf16_t* proj = (const bf16_t*)(a.ws + WS_PROJ); const float* gklr = (const float*)(a.ws + WS_GKLR); bf16_t* A2 = (bf16_t*)(a.ws + WS_A2);
    LAS float* Lgk = (LAS float*)(lds);
    LAS float* Lqt = (LAS float*)(lds + 1024);
    LAS float* Lkt = (LAS float*)(lds + 5120);
    LAS float* Lkd = (LAS float*)(lds + 9216);
    LAS float* Ldec = (LAS float*)(lds + 13312);
    LAS float* Lsc = (LAS float*)(lds + 13824);
    LAS float* Lo = (LAS float*)(lds + 16384);
    LAS float* Lv = (LAS float*)(lds + 81920);
    if (tid < 32) ((LAS f32x4*)Lgk)[tid] = ((const f32x4*)(gklr + (size_t)row0 * 16))[tid];
    __syncthreads();
    if (tid < 128) {
        const int d = tid; float w[16];
#pragma unroll
        for (int r = 0; r < 16; ++r) w[r] = a.in[I_WGK][(size_t)l * 16 * 512 + r * 512 + h * DK + d];
        const float bias = a.in[I_BGK][l * 512 + h * DK + d];
        float bb[8]; float run = 0.f;
#pragma unroll
        for (int t = 0; t < 8; ++t) { float x = bias;
#pragma unroll
            for (int r = 0; r < 16; ++r) x += Lgk[t * 16 + r] * w[r];
            run += logsig(x) * 0.0625f; bb[t] = run; }
#pragma unroll
        for (int t = 0; t < 8; ++t) { const size_t ro = (size_t)(row0 + t) * PLD + h * DK + d; const float q = bf2f(proj[ro + PC_Q]), k = bf2f(proj[ro + PC_K]);
            Lqt[d * 8 + t] = q * __expf(bb[t]); Lkt[t * 128 + d] = k * __expf(-bb[t]); Lkd[d * 8 + t] = k * __expf(run - bb[t]); }
        Ldec[d] = __expf(run);
    }
    __syncthreads();
    if (tid < 64) { const int i = tid >> 3, j = tid & 7; float s = 0.f;
        if (j <= i) for (int d = 0; d < 128; ++d) s += Lqt[d * 8 + i] * Lkt[j * 128 + d];
        Lsc[i * 8 + j] = s; }
    const int dv4 = lane * 4;
    f32x4 v[8];
#pragma unroll
    for (int t = 0; t < 8; ++t) { const u32x2 p = *(const u32x2*)(proj + (size_t)(row0 + t) * PLD + PC_V + h * DV + dv4); v[t] = (f32x4){bflo(p.x), bfhi(p.x), bflo(p.y), bfhi(p.y)}; }
    if (wave == 0) {
#pragma unroll
        for (int t = 0; t < 8; ++t) *(LAS f32x4*)(Lv + t * 256 + dv4) = v[t]; }
    const float* s0p = a.in[I_SG] + ((((size_t)l * 128 + b) * 4 + h) * DK) * DV;
    float* snp = a.out + O_SGS + ((((size_t)l * 128 + b) * 4 + h) * DK) * DV;
    f32x4 op[8];
#pragma unroll
    for (int t = 0; t < 8; ++t) op[t] = (f32x4){0.f, 0.f, 0.f, 0.f};
    f32x4 s0v[16];
#pragma unroll
    for (int i = 0; i < 16; ++i) s0v[i] = *(const f32x4*)(s0p + (size_t)(wave * 16 + i) * DV + dv4);
#pragma unroll
    for (int i = 0; i < 16; ++i) { const int dk = wave * 16 + i;
        const f32x4 s0 = s0v[i];
        const f32x4 qa = *(const LAS f32x4*)(Lqt + dk * 8), qb = *(const LAS f32x4*)(Lqt + dk * 8 + 4);
        const f32x4 ka = *(const LAS f32x4*)(Lkd + dk * 8), kb = *(const LAS f32x4*)(Lkd + dk * 8 + 4);
        f32x4 sn = s0 * Ldec[dk];
        op[0] += qa.x * s0; op[1] += qa.y * s0; op[2] += qa.z * s0; op[3] += qa.w * s0; op[4] += qb.x * s0; op[5] += qb.y * s0; op[6] += qb.z * s0; op[7] += qb.w * s0;
        sn += ka.x * v[0]; sn += ka.y * v[1]; sn += ka.z * v[2]; sn += ka.w * v[3]; sn += kb.x * v[4]; sn += kb.y * v[5]; sn += kb.z * v[6]; sn += kb.w * v[7];
        *(f32x4*)(snp + (size_t)dk * DV + dv4) = sn; }
#pragma unroll
    for (int t = 0; t < 8; ++t) *(LAS f32x4*)(Lo + (wave * 8 + t) * 256 + dv4) = op[t];
    __syncthreads();
    { const int t = wave; f32x4 o = {0.f, 0.f, 0.f, 0.f};
#pragma unroll
        for (int w8 = 0; w8 < 8; ++w8) o += *(const LAS f32x4*)(Lo + (w8 * 8 + t) * 256 + dv4);
        for (int j = 0; j <= t; ++j) o += Lsc[t * 8 + j] * *(const LAS f32x4*)(Lv + j * 256 + dv4);
        float ss = (o.x * o.x + o.y * o.y) + (o.z * o.z + o.w * o.w); ss = wave_sum(ss);
        const float r = rsqrtf(ss * (1.0f / DV) + EPS);
        const u32x2 gp = *(const u32x2*)(proj + (size_t)(row0 + t) * PLD + PC_G + h * DV + dv4);
        const f32x4 gn = *(const f32x4*)(a.in[I_GNORM] + l * DV + dv4);
        const float o0 = o.x * r * gn.x * silu_f(bflo(gp.x)), o1 = o.y * r * gn.y * silu_f(bfhi(gp.x)), o2 = o.z * r * gn.z * silu_f(bflo(gp.y)), o3 = o.w * r * gn.w * silu_f(bfhi(gp.y));
        u32x2 w; w.x = cvtpk(o0, o1); w.y = cvtpk(o2, o3); *(u32x2*)(A2 + (size_t)(row0 + t) * DM + h * DV + dv4) = w; }
    __syncthreads();
}

template <int W> __device__ __forceinline__ void pool_d_items(const bf16_t* proj, const float* spool, bf16_t* DP, int gi, int i0, int i1, int NT) {
    for (int idx = i0; idx < i1; idx += NT) {
        const int tok = idx >> 5, c8 = idx & 31, ch = gi * 256 + c8 * 8;
        u32x4 p[W]; f32x4 e0[W], e1[W]; float wt[W];
        if (tok < NPR) { const int t = tok & (SEQ - 1);
#pragma unroll
            for (int j = 0; j < W; ++j) { const int tau = t - j; wt[j] = tau >= 0 ? 1.f : 0.f; p[j] = *(const u32x4*)(proj + (size_t)(tok - (tau >= 0 ? j : 0)) * PLD + PC_U + ch); }
            float s[8];
#pragma unroll
            for (int e = 0; e < 8; ++e) s[e] = 0.f;
#pragma unroll
            for (int j = 0; j < W; ++j) { s[0] += wt[j] * bflo(p[j].x); s[1] += wt[j] * bfhi(p[j].x); s[2] += wt[j] * bflo(p[j].y); s[3] += wt[j] * bfhi(p[j].y); s[4] += wt[j] * bflo(p[j].z); s[5] += wt[j] * bfhi(p[j].z); s[6] += wt[j] * bflo(p[j].w); s[7] += wt[j] * bfhi(p[j].w); }
            const float ic = 1.0f / (float)((t + 1) < W ? (t + 1) : W); u32x4 o;
            o.x = cvtpk(s[0] * ic - bflo(p[0].x), s[1] * ic - bfhi(p[0].x)); o.y = cvtpk(s[2] * ic - bflo(p[0].y), s[3] * ic - bfhi(p[0].y));
            o.z = cvtpk(s[4] * ic - bflo(p[0].z), s[5] * ic - bfhi(p[0].z)); o.w = cvtpk(s[6] * ic - bflo(p[0].w), s[7] * ic - bfhi(p[0].w));
            *(u32x4*)(DP + ((size_t)gi * NTOK + tok) * 256 + c8 * 8) = o;
        } else { const int bs = (tok - NPR) >> 3, t = tok & 7;
#pragma unroll
            for (int j = 0; j < W; ++j) { const int tau = t - j;
                if (tau >= 0) { const u32x4 q = *(const u32x4*)(proj + (size_t)(tok - j) * PLD + PC_U + ch); e0[j] = (f32x4){bflo(q.x), bfhi(q.x), bflo(q.y), bfhi(q.y)}; e1[j] = (f32x4){bflo(q.z), bfhi(q.z), bflo(q.w), bfhi(q.w)}; }
                else { const float* bp = spool + ((size_t)bs * 15 + 15 + tau) * 1024 + ch; e0[j] = *(const f32x4*)bp; e1[j] = *(const f32x4*)(bp + 4); } }
            f32x4 s0 = e0[0], s1 = e1[0];
#pragma unroll
            for (int j = 1; j < W; ++j) { s0 += e0[j]; s1 += e1[j]; }
            const float ic = 1.0f / (float)W; s0 = s0 * ic - e0[0]; s1 = s1 * ic - e1[0]; u32x4 o;
            o.x = cvtpk(s0.x, s0.y); o.y = cvtpk(s0.z, s0.w); o.z = cvtpk(s1.x, s1.y); o.w = cvtpk(s1.z, s1.w);
            *(u32x4*)(DP + ((size_t)gi * NTOK + tok) * 256 + c8 * 8) = o;
        }
    }
}
__device__ __forceinline__ void pool_d_phase(const Args& a, int l, int NT, int bx, int wave) {
    const int gtid = bx * 512 + wave * 64 + lane_id();
    const bf16_t* proj = (const bf16_t*)(a.ws + WS_PROJ); bf16_t* DP = (bf16_t*)(a.ws + WS_DP);
    const float* spool = a.in[I_SP] + (size_t)l * 128 * 15 * 1024;
    pool_d_items<2>(proj, spool, DP, 0, gtid, NTOK * 32, NT);
    pool_d_items<4>(proj, spool, DP, 1, gtid, NTOK * 32, NT);
    pool_d_items<8>(proj, spool, DP, 2, gtid, NTOK * 32, NT);
    pool_d_items<16>(proj, spool, DP, 3, gtid, NTOK * 32, NT);
    float* spp = a.out + O_SPP + (size_t)l * 4 * 15 * 1024; float* sps = a.out + O_SPS + (size_t)l * 128 * 15 * 1024;
    for (int idx = gtid; idx < (4 + 128) * 15 * 128; idx += NT) {
        const int c8 = idx & 127, rj = idx >> 7, ch = c8 * 8;
        if (rj < 60) { const int bq = rj / 15, j = rj - bq * 15;
            const u32x4 p = *(const u32x4*)(proj + (size_t)(bq * SEQ + SEQ - 15 + j) * PLD + PC_U + ch); float* o = spp + ((size_t)bq * 15 + j) * 1024 + ch;
            *(f32x4*)o = (f32x4){bflo(p.x), bfhi(p.x), bflo(p.y), bfhi(p.y)}; *(f32x4*)(o + 4) = (f32x4){bflo(p.z), bfhi(p.z), bflo(p.w), bfhi(p.w)};
        } else { const int r2 = rj - 60, bs = r2 / 15, j = r2 - bs * 15; float* o = sps + ((size_t)bs * 15 + j) * 1024 + ch;
            if (j < 7) { const float* bp = spool + ((size_t)bs * 15 + 8 + j) * 1024 + ch; *(f32x4*)o = *(const f32x4*)bp; *(f32x4*)(o + 4) = *(const f32x4*)(bp + 4); }
            else { const u32x4 p = *(const u32x4*)(proj + (size_t)(NPR + bs * 8 + j - 7) * PLD + PC_U + ch);
                *(f32x4*)o = (f32x4){bflo(p.x), bfhi(p.x), bflo(p.y), bfhi(p.y)}; *(f32x4*)(o + 4) = (f32x4){bflo(p.z), bfhi(p.z), bflo(p.w), bfhi(p.w)}; } }
    }
}

__device__ __forceinline__ void gla_scan_phase(const Args& a, int l, int NT, int bx, int wave) {
    const int gtid = bx * 512 + wave * 64 + lane_id();
    const bf16_t* UT = (const bf16_t*)(a.ws + WS_UT); const float* DEC = (const float*)(a.ws + WS_DEC); bf16_t* ST = (bf16_t*)(a.ws + WS_ST);
    float* sgp = a.out + O_SGP + (size_t)l * 16 * DK * DV;
    for (int g = gtid; g < 16 * DV * 32; g += NT) {
        const int bh = g >> 13, dv = (g >> 5) & 255, dk4 = (g & 31) * 4;
        f32x4 s = {0.f, 0.f, 0.f, 0.f};
#pragma unroll 8
        for (int c = 0; c < NCH; ++c) { const size_t o = ((size_t)(bh * NCH + c) * DV + dv) * DK + dk4;
            const u32x2 uw = *(const u32x2*)(UT + o); const f32x4 u = {bflo(uw.x), bfhi(uw.x), bflo(uw.y), bfhi(uw.y)}; const f32x4 dc = *(const f32x4*)(DEC + (size_t)(bh * NCH + c) * DK + dk4);
            u32x2 w; w.x = cvtpk(s.x, s.y); w.y = cvtpk(s.z, s.w); *(u32x2*)(ST + o) = w;
            s = dc * s + u; }
        float* op = sgp + ((size_t)bh * DK + dk4) * DV + dv; op[0] = s.x; op[DV] = s.y; op[2 * DV] = s.z; op[3 * DV] = s.w;
    }
}

__device__ __forceinline__ void gla_c_unit(const Args& a, int l, int unit, LAS unsigned char* lds, int wave) {
    const int lane = lane_id(), tid = wave * 64 + lane;
    const int bh = unit >> 5, c = unit & 31, b = bh >> 2, h = bh & 3, tok0 = b * SEQ + c * 64;
    const bf16_t* proj = (const bf16_t*)(a.ws + WS_PROJ); const bf16_t* QT = (const bf16_t*)(a.ws + WS_QT); const bf16_t* KT = (const bf16_t*)(a.ws + WS_KT);
    const bf16_t* ST = (const bf16_t*)(a.ws + WS_ST); bf16_t* A2 = (bf16_t*)(a.ws + WS_A2);
    LAS bf16_t* Lq = (LAS bf16_t*)(lds);
    LAS bf16_t* Lk = (LAS bf16_t*)(lds + 17408);
    LAS bf16_t* Lp = (LAS bf16_t*)(lds + 34816);
    LAS bf16_t* Lv = (LAS bf16_t*)(lds + 45056);
    LAS float* Lss = (LAS float*)(lds + 78336);
    const int lr = lane & 15, lq = lane >> 4, dv0 = wave * 32;
    bf16x8 sf[2][4];
#pragma unroll
    for (int nd = 0; nd < 2; ++nd)
#pragma unroll
        for (int ks = 0; ks < 4; ++ks) sf[nd][ks] = *(const bf16x8*)(ST + ((size_t)unit * DV + dv0 + nd * 16 + lr) * DK + ks * 32 + 8 * lq);
#pragma unroll
    for (int i = 0; i < 2; ++i) { const int p = tid + 512 * i, row = p >> 4, c16 = p & 15;
        *(LAS u32x4*)(Lq + row * 136 + c16 * 8) = *(const u32x4*)(QT + (size_t)(unit * 64 + row) * DK + c16 * 8);
        *(LAS u32x4*)(Lk + row * 136 + c16 * 8) = *(const u32x4*)(KT + (size_t)(unit * 64 + row) * DK + c16 * 8); }
#pragma unroll
    for (int i = 0; i < 4; ++i) { const int p = tid + 512 * i, t = p >> 5, c16 = p & 31;
        const u32x4 v = *(const u32x4*)(proj + (size_t)(tok0 + t) * PLD + PC_V + h * DV + c16 * 8);
        LAS u32x2* d = (LAS u32x2*)(Lv + t * 260 + c16 * 8); d[0] = (u32x2){v.x, v.y}; d[1] = (u32x2){v.z, v.w}; }
    __syncthreads();
    { const int mi = wave >> 1;
#pragma unroll
        for (int jj = 0; jj < 2; ++jj) { const int nj = (wave & 1) * 2 + jj; f32x4 acc = {0.f, 0.f, 0.f, 0.f};
            if (nj <= mi) {
#pragma unroll
                for (int ks = 0; ks < 4; ++ks) { const bf16x8 kf = *(const LAS bf16x8*)(Lk + (nj * 16 + lr) * 136 + ks * 32 + 8 * lq), qf = *(const LAS bf16x8*)(Lq + (mi * 16 + lr) * 136 + ks * 32 + 8 * lq);
                    acc = __builtin_amdgcn_mfma_f32_16x16x32_bf16(kf, qf, acc, 0, 0, 0); }
                const int i = mi * 16 + lr, j0 = nj * 16 + lq * 4;
#pragma unroll
                for (int r = 0; r < 4; ++r) if (j0 + r > i) acc[r] = 0.f;
            }
            u32x2 w; w.x = cvtpk(acc[0], acc[1]); w.y = cvtpk(acc[2], acc[3]); *(LAS u32x2*)(Lp + (mi * 16 + lr) * 72 + nj * 16 + lq * 4) = w; } }
    __syncthreads();
    f32x4 o[4][2];
#pragma unroll
    for (int mi = 0; mi < 4; ++mi)
#pragma unroll
        for (int nd = 0; nd < 2; ++nd) o[mi][nd] = (f32x4){0.f, 0.f, 0.f, 0.f};
#pragma unroll
    for (int ks = 0; ks < 2; ++ks) { bf16x8 vf[2];
#pragma unroll
        for (int nd = 0; nd < 2; ++nd)
#pragma unroll
            for (int j = 0; j < 8; ++j) vf[nd][j] = (short)Lv[(ks * 32 + 8 * lq + j) * 260 + dv0 + nd * 16 + lr];
#pragma unroll
        for (int mi = 0; mi < 4; ++mi) { const bf16x8 pf = *(const LAS bf16x8*)(Lp + (mi * 16 + lr) * 72 + ks * 32 + 8 * lq);
#pragma unroll
            for (int nd = 0; nd < 2; ++nd) o[mi][nd] = __builtin_amdgcn_mfma_f32_16x16x32_bf16(vf[nd], pf, o[mi][nd], 0, 0, 0); } }
#pragma unroll
    for (int ks = 0; ks < 4; ++ks)
#pragma unroll
        for (int mi = 0; mi < 4; ++mi) { const bf16x8 qf = *(const LAS bf16x8*)(Lq + (mi * 16 + lr) * 136 + ks * 32 + 8 * lq);
#pragma unroll
            for (int nd = 0; nd < 2; ++nd) o[mi][nd] = __builtin_amdgcn_mfma_f32_16x16x32_bf16(sf[nd][ks], qf, o[mi][nd], 0, 0, 0); }
#pragma unroll
    for (int mi = 0; mi < 4; ++mi) { float ss = 0.f;
#pragma unroll
        for (int nd = 0; nd < 2; ++nd) { const f32x4 x = o[mi][nd]; ss += (x.x * x.x + x.y * x.y) + (x.z * x.z + x.w * x.w); }
        ss = xor16_sum(ss); ss = xor32_sum(ss);
        if (lq == 0) Lss[(mi * 16 + lr) * 8 + wave] = ss; }
    __syncthreads();
#pragma unroll
    for (int mi = 0; mi < 4; ++mi) { const int t = mi * 16 + lr; const f32x4 s0 = *(const LAS f32x4*)(Lss + t * 8), s1 = *(const LAS f32x4*)(Lss + t * 8 + 4);
        const float r = rsqrtf((((s0.x + s0.y) + (s0.z + s0.w)) + ((s1.x + s1.y) + (s1.z + s1.w))) * (1.0f / DV) + EPS);
#pragma unroll
        for (int nd = 0; nd < 2; ++nd) { const int dvg = dv0 + nd * 16 + lq * 4;
            const u32x2 gp = *(const u32x2*)(proj + (size_t)(tok0 + t) * PLD + PC_G + h * DV + dvg);
            const f32x4 gn = *(const f32x4*)(a.in[I_GNORM] + l * DV + dvg); const f32x4 x = o[mi][nd];
            const float o0 = x.x * r * gn.x * silu_f(bflo(gp.x)), o1 = x.y * r * gn.y * silu_f(bfhi(gp.x)), o2 = x.z * r * gn.z * silu_f(bflo(gp.y)), o3 = x.w * r * gn.w * silu_f(bfhi(gp.y));
            u32x2 w; w.x = cvtpk(o0, o1); w.y = cvtpk(o2, o3); *(u32x2*)(A2 + (size_t)(tok0 + t) * DM + h * DV + dvg) = w; } }
    __syncthreads();
}

__device__ __forceinline__ void final_norm_phase(const Args& a, int gw, int NGW) {
    const int lane = lane_id();
    float* X = a.out + O_Y; const float* ssp = (const float*)(a.ws + WS_SSP); const float* gn = a.in[I_NFIN];
    for (int m = gw; m < NTOK; m += NGW) {
        float ss = (lane < 32) ? ssp[(size_t)m * 32 + lane] : 0.f; ss = wave_sum(ss);
        const float r = rsqrtf(ss * (1.0f / DM) + EPS);
#pragma unroll
        for (int j = 0; j < 8; ++j) { f32x4* p = (f32x4*)(X + (size_t)m * DM) + lane + 64 * j; const f32x4 g4 = ((const f32x4*)gn)[lane + 64 * j]; const f32x4 v = *p; *p = (v * r) * g4; }
    }
}

#ifndef PM
#define PM 0xFFFF
#endif
#define PH(b) if constexpr ((PM >> (b)) & 1)
#ifndef DUP
#define DUP 0
#endif
#define REP(b) for (int rep_ = 0; rep_ < (((DUP >> (b)) & 1) ? 2 : 1); ++rep_)
__global__ void __launch_bounds__(512, 2) fwd_megakernel(Args args) {
    extern __shared__ __attribute__((aligned(16))) unsigned char lds_raw[];
    LAS unsigned char* lds = (LAS unsigned char*)lds_raw;
    volatile LAS unsigned* MISC = (volatile LAS unsigned*)(lds + MISC_OFF);
    const int tid = threadIdx.x, wave0 = __builtin_amdgcn_readfirstlane(tid >> 6);
    const int G = gridDim.x, bx = blockIdx.x;
    for (int u = tid; u < (LDS_BYTES - LDSCTL_OFF) / 4; u += 512) ((LAS unsigned*)(lds + LDSCTL_OFF))[u] = 0u;
    __syncthreads();
    XcdBarrier bar = xcd_barrier_post((unsigned*)(args.ws + WS_CTL) + CW_BAR, MISC + 8);
#define OPQ() int G_ = G, bx_ = bx, wave = wave0; unsigned char* ws = args.ws; asm volatile("" : "+s"(G_), "+s"(bx_), "+s"(ws), "+s"(wave))

    REP(0) PH(0) p0_prologue(args, lds, bx * 8 + wave0, G * 8, wave0);
    xcd_barrier(bar);
#pragma unroll 1
    for (int l = 0; l < 2; ++l) {
        REP(1) PH(1) {
            OPQ(); unsigned char* wl = ws + WS_W + (size_t)l * W_LAYER;
            pg8::Gemm g{(const bf16_t*)(ws + WS_XB), (const bf16_t*)(wl + WO_IN)}; pg8::StaticOrder S; S.init(NTOK, INW, G_, bx_);
            pg8::EpiInProj E{(bf16_t*)(ws + WS_PROJ), (float*)(ws + WS_GKLR), (const float*)(ws + WS_SSP)};
            pg8::gemm_phase<pg8::EpiInProj, pg8::StaticOrder, DM, DM, DM, 0>(lds, g, S, E, wave);
        }
        xcd_barrier(bar);
        {
            OPQ();
            REP(2) PH(2) for (int u = bx_; u < 512; u += G_) gla_sample_unit(args, l, u, lds, wave);
            REP(3) PH(3) for (int u = bx_; u < 512; u += G_) gla_a_unit(args, l, u, lds, wave);
            REP(4) PH(4) pool_d_phase(args, l, G_ * 512, bx_, wave);
        }
        xcd_barrier(bar);
        {
            OPQ(); unsigned char* wl = ws + WS_W + (size_t)l * W_LAYER;
            REP(5) PH(5) gla_scan_phase(args, l, G_ * 512, bx_, wave);
            __syncthreads();
            REP(6) PH(6) {
            pg8::Gemm g{(const bf16_t*)(ws + WS_DP), (const bf16_t*)(wl + WO_PL)}; pg8::PoolOrder S{G_, bx_};
            pg8::EpiPool E{(bf16_t*)(ws + WS_A2), args.in[I_PSCALE] + l * 1024};
            pg8::gemm_phase<pg8::EpiPool, pg8::PoolOrder, 256, 256, 256, 131072>(lds, g, S, E, wave); }
        }
        xcd_barrier(bar);
        {
            OPQ();
            REP(7) PH(7) for (int u = bx_; u < 512; u += G_) gla_c_unit(args, l, u, lds, wave);
        }
        xcd_barrier(bar);
        PH(8) {
            OPQ(); unsigned char* wl = ws + WS_W + (size_t)l * W_LAYER; float* X = args.out + O_Y;
            pg8::Gemm g{(const bf16_t*)(ws + WS_A2), (const bf16_t*)(wl + WO_OUT)}; pg8::StaticOrder S; S.init(NTOK, DM, G_, bx_);
            pg8::EpiResid E{l == 0 ? args.in[I_XP] : X, l == 0 ? args.in[I_XS] - (size_t)NPR * DM : X, X, (bf16_t*)(ws + WS_XB), (float*)(ws + WS_SSP)};
            pg8::gemm_phase<pg8::EpiResid, pg8::StaticOrder, DM, DM, DM, 0>(lds, g, S, E, wave);
        }
        xcd_barrier(bar);
        REP(9) PH(9) {
            OPQ(); unsigned char* wl = ws + WS_W + (size_t)l * W_LAYER;
            pg8::Gemm g{(const bf16_t*)(ws + WS_XB), (const bf16_t*)(wl + WO_GU)}; pg8::StaticOrder S; S.init(NTOK, 2 * DFF, G_, bx_);
            pg8::EpiGateUp E{(bf16_t*)(ws + WS_ACT), (const float*)(ws + WS_SSP)};
            pg8::gemm_phase<pg8::EpiGateUp, pg8::StaticOrder, DM, DM, DM, 0>(lds, g, S, E, wave);
        }
        xcd_barrier(bar);
        PH(10) {
            OPQ(); unsigned char* wl = ws + WS_W + (size_t)l * W_LAYER; float* X = args.out + O_Y;
            pg8::Gemm g{(const bf16_t*)(ws + WS_ACT), (const bf16_t*)(wl + WO_DN)}; pg8::StaticOrder S; S.init(NTOK, DM, G_, bx_);
            pg8::EpiResid E{X, X, X, (bf16_t*)(ws + WS_XB), (float*)(ws + WS_SSP)};
            pg8::gemm_phase<pg8::EpiResid, pg8::StaticOrder, DFF, DFF, DFF, 0>(lds, g, S, E, wave);
        }
        xcd_barrier(bar);
        REP(12) xcd_barrier(bar);
    }
    PH(11) { OPQ(); final_norm_phase(args, bx_ * 8 + wave, G_ * 8); }
}

extern "C" void kernel_launch(void* const* d_in, const int* in_sizes, int n_in, void* d_out, int out_size, void* d_ws, size_t ws_size, hipStream_t stream) {
    static int grid = 0;
    if (grid == 0) {
        if (n_in != 17 || out_size != (int)O_END || ws_size < WS_END) { fprintf(stderr, "kernel_launch: unexpected shapes: n_in %d out %d ws %zu\n", n_in, out_size, ws_size); grid = -1; return; }
        int dev = 0, cus = 0;
        if (hipGetDevice(&dev) != hipSuccess || hipDeviceGetAttribute(&cus, hipDeviceAttributeMultiprocessorCount, dev) != hipSuccess) { grid = -1; return; }
        if (hipFuncSetAttribute((const void*)fwd_megakernel, hipFuncAttributeMaxDynamicSharedMemorySize, LDS_BYTES) != hipSuccess) { fprintf(stderr, "kernel_launch: hipFuncSetAttribute failed\n"); grid = -1; return; }
        int per_cu = 0;
        if (hipOccupancyMaxActiveBlocksPerMultiprocessor(&per_cu, (const void*)fwd_megakernel, 512, LDS_BYTES) != hipSuccess || per_cu < 1) fprintf(stderr, "kernel_launch: occupancy query reports %d\n", per_cu);
        (void)hipGetLastError();
        grid = cus;
    }
    if (grid < 0) return;
    if (hipMemsetAsync((char*)d_ws + WS_CTL, 0, CTL_ZERO_BYTES, stream) != hipSuccess) return;
    Args a{};
    for (int i = 0; i < 17; ++i) a.in[i] = (const float*)d_in[i];
    a.out = (float*)d_out; a.ws = (unsigned char*)d_ws;
    hipLaunchKernelGGL(fwd_megakernel, dim3(grid), dim3(512), LDS_BYTES, stream, a);
}
```
